# Optimizing an MI355X kernel written in HIP

```python
import math
import jax
import jax.numpy as jnp
from jax import lax
import numpy as np

D_MODEL = 4096
BATCH = 2
SEQ = 4096
DEPTH = 1
DEC_BATCH = 8
DEC_SEQ = 64
PAST_LEN = 1024

CHUNK = 64
WINDOW = 128
WINDOW_CHUNKS = WINDOW // CHUNK
HEAD_DIM = 64
ATTN_WIDTH = D_MODEL // 2
N_Q_HEADS = ATTN_WIDTH // HEAD_DIM
N_KV_HEADS = max(1, N_Q_HEADS // 8)
GQA_REP = N_Q_HEADS // N_KV_HEADS
KV_WIDTH = N_KV_HEADS * HEAD_DIM
SSM_WIDTH = D_MODEL // 2
SSM_GROUP = 16
N_GROUPS = SSM_WIDTH // SSM_GROUP
STATE_DIM = 64
ROPE_THETA = 10000.0
NORM_EPS = 1e-5
DT_MIN = 1e-3
DT_MAX = 1e-1
IN_WIDTH = 2 * ATTN_WIDTH + 2 * KV_WIDTH + 2 * SSM_WIDTH + 2 * D_MODEL

kernel_name = 'chunk_streaming_swa_sink_s5_hybrid_step'


def _rmsnorm(x, g):
    xf = x.astype(jnp.float32)
    y = xf * lax.rsqrt(jnp.mean(xf * xf, axis=-1, keepdims=True) + NORM_EPS)
    return (y * g.astype(jnp.float32)).astype(x.dtype)


def _rope(x, pos):
    half = HEAD_DIM // 2
    inv_freq = ROPE_THETA ** (-jnp.arange(half, dtype=jnp.float32) / half)
    ang = pos.astype(jnp.float32)[:, None] * inv_freq[None, :]
    cos = jnp.cos(ang)[None, :, None, :]
    sin = jnp.sin(ang)[None, :, None, :]
    xf = x.astype(jnp.float32)
    x1, x2 = xf[..., :half], xf[..., half:]
    return jnp.concatenate([x1 * cos - x2 * sin, x2 * cos + x1 * sin], axis=-1).astype(x.dtype)


def _attend(q, k, v, sink, mask):
    s = jnp.einsum('...qgrd,...kgd->...grqk', q, k, preferred_element_type=jnp.float32)
    s = s * (HEAD_DIM ** -0.5)
    if mask is not None:
        s = jnp.where(mask, s, -jnp.inf)
    sk = jnp.broadcast_to(sink.astype(jnp.float32)[:, :, None, None], s.shape[:-1] + (1,))
    p = jax.nn.softmax(jnp.concatenate([s, sk], axis=-1), axis=-1)[..., :-1]
    return jnp.einsum('...grqk,...kgd->...qgrd', p.astype(v.dtype), v)


def _swa_prompt(q, k, v, sink):
    b, t = q.shape[0], q.shape[1]
    nc = t // CHUNK
    qc = q.reshape(b, nc, CHUNK, N_KV_HEADS, GQA_REP, HEAD_DIM)
    kc = k.reshape(b, nc, CHUNK, N_KV_HEADS, HEAD_DIM)
    vc = v.reshape(b, nc, CHUNK, N_KV_HEADS, HEAD_DIM)
    pad = ((0, 0), (WINDOW_CHUNKS, 0), (0, 0), (0, 0), (0, 0))
    kp = jnp.pad(kc, pad)
    vp = jnp.pad(vc, pad)
    kb = jnp.concatenate([kp[:, j:j + nc] for j in range(WINDOW_CHUNKS + 1)], axis=2)
    vb = jnp.concatenate([vp[:, j:j + nc] for j in range(WINDOW_CHUNKS + 1)], axis=2)
    key_chunk = (jnp.arange(nc)[:, None] - WINDOW_CHUNKS
                 + (jnp.arange((WINDOW_CHUNKS + 1) * CHUNK) // CHUNK)[None, :])
    mask = (key_chunk >= 0)[:, None, None, None, :]
    o = _attend(qc, kb, vb, sink, mask)
    return o.reshape(b, t, ATTN_WIDTH)


def _swa_cached(q, k, v, cache_k, cache_v, sink):
    b, t = q.shape[0], q.shape[1]
    kb = jnp.concatenate([cache_k.astype(k.dtype), k], axis=1)
    vb = jnp.concatenate([cache_v.astype(v.dtype), v], axis=1)
    qg = q.reshape(b, t, N_KV_HEADS, GQA_REP, HEAD_DIM)
    o = _attend(qg, kb, vb, sink, None)
    return o.reshape(b, t, ATTN_WIDTH)


def _s5_discretise(lambda_re, lambda_im, log_dt, b_re, b_im):
    lr = jnp.minimum(lambda_re.astype(jnp.float32), -1e-4)
    li = lambda_im.astype(jnp.float32)
    dt = jnp.exp(log_dt.astype(jnp.float32))[:, None]
    mag = jnp.exp(lr * dt)
    a_re = mag * jnp.cos(li * dt)
    a_im = mag * jnp.sin(li * dt)
    den = lr * lr + li * li
    nr = a_re - 1.0
    f_re = (nr * lr + a_im * li) / den
    f_im = (a_im * lr - nr * li) / den
    br = b_re.astype(jnp.float32)
    bi = b_im.astype(jnp.float32)
    bb_re = f_re[..., None] * br - f_im[..., None] * bi
    bb_im = f_re[..., None] * bi + f_im[..., None] * br
    return a_re, a_im, bb_re, bb_im


def _cmul_combine(left, right):
    al_re, al_im, bl_re, bl_im = left
    ar_re, ar_im, br_re, br_im = right
    return (al_re * ar_re - al_im * ar_im,
            al_re * ar_im + al_im * ar_re,
            ar_re * bl_re - ar_im * bl_im + br_re,
            ar_re * bl_im + ar_im * bl_re + br_im)


def _s5_scan(u, h0_re, h0_im, a_re, a_im, bb_re, bb_im, c_re, c_im, d_skip):
    b, t = u.shape[0], u.shape[1]
    uf = u.astype(jnp.float32).reshape(b, t, N_GROUPS, SSM_GROUP)
    x_re = jnp.einsum('btgi,gpi->btgp', uf, bb_re)
    x_im = jnp.einsum('btgi,gpi->btgp', uf, bb_im)
    h0r = h0_re.astype(jnp.float32)
    h0i = h0_im.astype(jnp.float32)
    x_re = x_re.at[:, 0].add(a_re * h0r - a_im * h0i)
    x_im = x_im.at[:, 0].add(a_re * h0i + a_im * h0r)
    a_re_t = jnp.broadcast_to(a_re, (1, t) + a_re.shape)
    a_im_t = jnp.broadcast_to(a_im, (1, t) + a_im.shape)
    _, _, h_re, h_im = lax.associative_scan(_cmul_combine, (a_re_t, a_im_t, x_re, x_im), axis=1)
    y = (jnp.einsum('btgp,gip->btgi', h_re, c_re.astype(jnp.float32))
         - jnp.einsum('btgp,gip->btgi', h_im, c_im.astype(jnp.float32))
         + d_skip.astype(jnp.float32) * uf)
    return y.reshape(b, t, SSM_WIDTH).astype(u.dtype), h_re[:, -1], h_im[:, -1]


def _layer(x, pos, kv_cache_k, kv_cache_v, h0_re, h0_im, disc, norm_g, w_in, sink,
           c_re, c_im, d_skip, w_glu, b_glu, w_pa, w_ps, w_out):
    b, t, _ = x.shape
    h = _rmsnorm(x, norm_g)
    proj = jnp.einsum('btd,de->bte', h, w_in)
    sizes = (ATTN_WIDTH, KV_WIDTH, KV_WIDTH, ATTN_WIDTH, SSM_WIDTH, SSM_WIDTH, D_MODEL, D_MODEL)
    points = [int(p) for p in np.cumsum(sizes)[:-1]]
    q, k, v, z_a, u, z_s, g_a, g_s = jnp.split(proj, points, axis=-1)
    q = _rope(q.reshape(b, t, N_Q_HEADS, HEAD_DIM), pos)
    k = _rope(k.reshape(b, t, N_KV_HEADS, HEAD_DIM), pos)
    v = v.reshape(b, t, N_KV_HEADS, HEAD_DIM)
    sink_g = sink.reshape(N_KV_HEADS, GQA_REP)
    if kv_cache_k is None:
        attn = _swa_prompt(q, k, v, sink_g)
    else:
        attn = _swa_cached(q, k, v, kv_cache_k, kv_cache_v, sink_g)
    a_re, a_im, bb_re, bb_im = disc
    y_ssm, hl_re, hl_im = _s5_scan(u, h0_re, h0_im, a_re, a_im, bb_re, bb_im, c_re, c_im, d_skip)
    glu = jnp.einsum('btc,ce->bte', y_ssm, w_glu) + b_glu
    glu_a, glu_g = jnp.split(glu, 2, axis=-1)
    ssm_out = glu_a * jax.nn.sigmoid(glu_g)
    br_a = jnp.einsum('btc,cd->btd', attn * jax.nn.silu(z_a), w_pa)
    br_s = jnp.einsum('btc,cd->btd', ssm_out * jax.nn.silu(z_s), w_ps)
    merged = jax.nn.sigmoid(g_a) * br_a + jax.nn.sigmoid(g_s) * br_s
    out = x + jnp.einsum('btd,de->bte', merged, w_out)
    return out, k, v, hl_re, hl_im


def setup_inputs(seed: int = 0) -> dict:
    key = jax.random.key(seed)
    ks = jax.random.split(key, 23)
    f32 = jnp.float32
    rows = min(WINDOW, PAST_LEN)

    def nrm(k, shape, scale):
        return scale * jax.random.normal(k, shape, f32)

    return {
        'x_prompt': nrm(ks[0], (BATCH, SEQ, D_MODEL), 1.0),
        'x_sample': nrm(ks[1], (DEC_BATCH, DEC_SEQ, D_MODEL), 1.0),
        'cache_k': nrm(ks[2], (DEPTH, DEC_BATCH, rows, N_KV_HEADS, HEAD_DIM), 1.0),
        'cache_v': nrm(ks[3], (DEPTH, DEC_BATCH, rows, N_KV_HEADS, HEAD_DIM), 1.0),
        'state_ssm_re': nrm(ks[4], (DEPTH, DEC_BATCH, N_GROUPS, STATE_DIM), 0.3),
        'state_ssm_im': nrm(ks[5], (DEPTH, DEC_BATCH, N_GROUPS, STATE_DIM), 0.3),
        'norm_g': 1.0 + nrm(ks[6], (DEPTH, D_MODEL), 0.02),
        'w_in': nrm(ks[7], (DEPTH, D_MODEL, IN_WIDTH), D_MODEL ** -0.5),
        'sink': nrm(ks[8], (DEPTH, N_Q_HEADS), 1.0),
        'lambda_re': -0.5 + nrm(ks[9], (DEPTH, N_GROUPS, STATE_DIM), 0.01),
        'lambda_im': math.pi * jnp.arange(STATE_DIM, dtype=f32) + nrm(ks[10], (DEPTH, N_GROUPS, STATE_DIM), 0.01),
        'log_dt': jax.random.uniform(ks[11], (DEPTH, N_GROUPS), f32, math.log(DT_MIN), math.log(DT_MAX)),
        'b_re': nrm(ks[12], (DEPTH, N_GROUPS, STATE_DIM, SSM_GROUP), (2 * SSM_GROUP) ** -0.5),
        'b_im': nrm(ks[13], (DEPTH, N_GROUPS, STATE_DIM, SSM_GROUP), (2 * SSM_GROUP) ** -0.5),
        'c_re': nrm(ks[14], (DEPTH, N_GROUPS, SSM_GROUP, STATE_DIM), STATE_DIM ** -0.5),
        'c_im': nrm(ks[15], (DEPTH, N_GROUPS, SSM_GROUP, STATE_DIM), STATE_DIM ** -0.5),
        'd_skip': nrm(ks[16], (DEPTH, N_GROUPS, SSM_GROUP), 1.0),
        'w_glu': nrm(ks[17], (DEPTH, SSM_WIDTH, 2 * SSM_WIDTH), SSM_WIDTH ** -0.5),
        'b_glu': nrm(ks[18], (DEPTH, 2 * SSM_WIDTH), 0.01),
        'w_pa': nrm(ks[19], (DEPTH, ATTN_WIDTH, D_MODEL), ATTN_WIDTH ** -0.5),
        'w_ps': nrm(ks[20], (DEPTH, SSM_WIDTH, D_MODEL), SSM_WIDTH ** -0.5),
        'w_out': nrm(ks[21], (DEPTH, D_MODEL, D_MODEL), D_MODEL ** -0.5),
        'final_g': 1.0 + nrm(ks[22], (D_MODEL,), 0.02),
    }


def reference(x_prompt, x_sample, cache_k, cache_v, state_ssm_re, state_ssm_im,
              norm_g, w_in, sink, lambda_re, lambda_im, log_dt, b_re, b_im, c_re, c_im,
              d_skip, w_glu, b_glu, w_pa, w_ps, w_out, final_g):
    bp, sp = x_prompt.shape[0], x_prompt.shape[1]
    ts = x_sample.shape[1]
    pos_p = jnp.arange(sp, dtype=jnp.int32)
    pos_s = PAST_LEN + jnp.arange(ts, dtype=jnp.int32)
    zeros = jnp.zeros((bp, N_GROUPS, STATE_DIM), jnp.float32)
    keep = min(WINDOW, sp)
    xp, xs = x_prompt, x_sample
    kp_l, vp_l, hpr_l, hpi_l = [], [], [], []
    ks_l, vs_l, hsr_l, hsi_l = [], [], [], []
    for l in range(DEPTH):
        disc = _s5_discretise(lambda_re[l], lambda_im[l], log_dt[l], b_re[l], b_im[l])
        shared = (norm_g[l], w_in[l], sink[l], c_re[l], c_im[l], d_skip[l],
                  w_glu[l], b_glu[l], w_pa[l], w_ps[l], w_out[l])
        xp, kp, vp, hpr, hpi = _layer(xp, pos_p, None, None, zeros, zeros, disc, *shared)
        xs, kn, vn, hsr, hsi = _layer(xs, pos_s, cache_k[l], cache_v[l],
                                      state_ssm_re[l], state_ssm_im[l], disc, *shared)
        kp_l.append(kp[:, sp - keep:])
        vp_l.append(vp[:, sp - keep:])
        hpr_l.append(hpr)
        hpi_l.append(hpi)
        ks_l.append(kn)
        vs_l.append(vn)
        hsr_l.append(hsr)
        hsi_l.append(hsi)
    y_prompt = _rmsnorm(xp, final_g)
    y_sample = _rmsnorm(xs, final_g)
    return (y_prompt, y_sample,
            jnp.stack(kp_l), jnp.stack(vp_l), jnp.stack(hpr_l), jnp.stack(hpi_l),
            jnp.stack(ks_l), jnp.stack(vs_l), jnp.stack(hsr_l), jnp.stack(hsi_l))
```

```cpp
#include <hip/hip_runtime.h>
#include <hip/hip_cooperative_groups.h>
#include <cstdio>
#include <cstdint>
namespace cg = cooperative_groups;

#ifndef MK_MULTI
#define MK_MULTI 0
#endif

#define LAS __attribute__((address_space(3)))
typedef unsigned short bf16_t;
typedef short bf16x8 __attribute__((ext_vector_type(8)));
typedef float f32x4 __attribute__((ext_vector_type(4)));
typedef float f32x2 __attribute__((ext_vector_type(2)));
typedef unsigned u32x4 __attribute__((ext_vector_type(4)));
typedef unsigned u32x2 __attribute__((ext_vector_type(2)));

constexpr int DM = 4096, NB = 2, SEQ = 4096, DB = 8, DS = 64, PAST = 1024;
constexpr int MP = NB * SEQ, MS = DB * DS, MT = MP + MS;
constexpr int HD = 64, AW = 2048, NQH = 32, NKV = 4, KVW = 256, SW = 2048, NG = 128, SD = 64;
constexpr int INW = 16896;
constexpr int C_Q = 0, C_K = 2048, C_V = 2304, C_ZA = 2560, C_U = 4608, C_ZS = 6656, C_GA = 8704, C_GS = 12800;
constexpr int NCH = SEQ / 64;
constexpr float EPS = 1e-5f;

constexpr size_t MiB = 1u << 20;
constexpr size_t WS_ROWSS = 0;
constexpr size_t WS_ARE = 1 * MiB, WS_AIM = WS_ARE + 32768, WS_A64R = WS_AIM + 32768, WS_A64I = WS_A64R + 32768;
constexpr size_t WS_BBR = 2 * MiB, WS_BBI = 3 * MiB;
constexpr size_t WS_ROPC = 4 * MiB, WS_ROPS = WS_ROPC + 512 * 1024;
constexpr size_t WS_E = 6 * MiB;
constexpr size_t WS_WIN = 16 * MiB;
constexpr size_t WS_WGLU = 148 * MiB;
constexpr size_t WS_WM = 164 * MiB;
constexpr size_t WS_WOUT = 196 * MiB;
constexpr size_t WS_XN = 228 * MiB;
constexpr size_t WS_PROJ = 296 * MiB;
constexpr size_t WS_KV = 577 * MiB;
constexpr size_t WS_ACT = 594 * MiB;
constexpr size_t WS_YSSM = 662 * MiB;
constexpr size_t WS_END = 696 * MiB;

constexpr size_t O_Y = 0;
constexpr size_t O_KP = (size_t)MT * DM;
constexpr size_t O_VP = O_KP + 2 * 128 * 256;
constexpr size_t O_HRP = O_VP + 2 * 128 * 256;
constexpr size_t O_HIP = O_HRP + 2 * 128 * 64;
constexpr size_t O_KS = O_HIP + 2 * 128 * 64;
constexpr size_t O_VS = O_KS + 8 * 64 * 256;
constexpr size_t O_HRS = O_VS + 8 * 64 * 256;
constexpr size_t O_HIS = O_HRS + 8 * 128 * 64;
constexpr size_t O_END = O_HIS + 8 * 128 * 64;

constexpr int NWAVES = 8;
constexpr int LDS_BYTES = 147456;

namespace pg8 {
constexpr int BM = 256, BK = 64, HALF = 128, HTB = HALF * BK * 2, STAGE_BYTES = 8 * HTB, NXCD = 8, WGM = 8;
__host__ __device__ __forceinline__ int lds_byte(int r, int c) { const int st = (r >> 4) * 2 + (c >> 5), rr = r & 15, cc = c & 31, ob = rr * 64 + cc * 2; return st * 1024 + (ob ^ (((ob >> 9) & 1) << 5)); }
__host__ __device__ __forceinline__ void stage_rc(int b, int& R, int& C) { const int st = b / 1024, sb = b % 1024, swz = sb ^ (((sb >> 9) & 1) << 5); R = (st >> 1) * 16 + swz / 64; C = (st & 1) * 32 + (swz % 64) / 2; }
__host__ __device__ __forceinline__ int perm32(int rho) { const int n = rho >> 4, i = rho & 15; return 8 * (i >> 2) + 4 * n + (i & 3); }

struct Unit { int pm, pn, acol, brow, flag; };
struct Gemm { const bf16_t* A; const bf16_t* Bt; int lda, ldb, K; };

struct StaticOrder {
    int nM, nN, nwg, G, c;
    __device__ void init(int M, int N, int G_, int c_) { nM = M / BM; nN = N / BM; nwg = nM * nN; G = G_; c = c_; }
    __device__ bool tile(int i, int& pm, int& pn) const {
        const long L = (long)i * G + c; if (L >= nwg) return false;
        int wgid = (int)L; { const int q = nwg / NXCD, r = nwg % NXCD, xcd = wgid % NXCD, off = wgid / NXCD; wgid = (xcd < r ? xcd * (q + 1) : r * (q + 1) + (xcd - r) * q) + off; }
        const int nig = WGM * nN, gid = wgid / nig, fm = gid * WGM, gsz = (nM - fm) < WGM ? (nM - fm) : WGM;
        pm = fm + ((wgid % nig) % gsz); pn = (wgid % nig) / gsz; return true;
    }
    __device__ bool next(int i, Unit& u) const { if (!tile(i, u.pm, u.pn)) return false; u.acol = 0; u.brow = u.pn * BM; u.flag = 0; return true; }
};
struct MergeOrder {
    StaticOrder S;
    __device__ bool next(int i, Unit& u) const { if (!S.tile(i >> 1, u.pm, u.pn)) return false; const int h = i & 1; u.acol = h * 2048; u.brow = u.pn * 512 + h * 256; u.flag = h; return true; }
};

__device__ __forceinline__ unsigned cvt_pk_bf16(float lo, float hi) { unsigned r; asm volatile("v_cvt_pk_bf16_f32 %0, %1, %2" : "=v"(r) : "v"(lo), "v"(hi)); return r; }
__device__ __forceinline__ float bf_lo(unsigned w) { return __uint_as_float(w << 16); }
__device__ __forceinline__ float bf_hi(unsigned w) { return __uint_as_float(w & 0xffff0000u); }
__device__ __forceinline__ float sigm(float x) { return 1.0f / (1.0f + __expf(-x)); }
__device__ __forceinline__ void unpack8(const u32x4 w, float* f) { f[0] = bf_lo(w.x); f[1] = bf_hi(w.x); f[2] = bf_lo(w.y); f[3] = bf_hi(w.y); f[4] = bf_lo(w.z); f[5] = bf_hi(w.z); f[6] = bf_lo(w.w); f[7] = bf_hi(w.w); }

struct EpiProj {
    bf16_t* P; float* KV;
    static __device__ __forceinline__ bool keep(const Unit&) { return false; }
    __device__ __forceinline__ void operator()(f32x4 (&acc)[2][2][4][2], const Unit& u, int wr, int wc, int fr, int fq) const {
        const int row0 = u.pm * BM + wr * 64 + fr;
        if (u.pn == 8 || u.pn == 9) {
            const int col0 = (u.pn - 8) * 256 + wc * 32 + 8 * fq;
#pragma unroll
            for (int ai = 0; ai < 2; ++ai)
#pragma unroll
                for (int m = 0; m < 4; ++m) { float* rowp = KV + (size_t)(row0 + ai * HALF + m * 16) * 512 + col0;
#pragma unroll
                    for (int bj = 0; bj < 2; ++bj) { *(f32x4*)(rowp + bj * HALF) = acc[ai][bj][m][0]; *(f32x4*)(rowp + bj * HALF + 4) = acc[ai][bj][m][1]; } }
        } else {
            const int col0 = u.pn * BM + wc * 32 + 8 * fq;
#pragma unroll
            for (int ai = 0; ai < 2; ++ai)
#pragma unroll
                for (int m = 0; m < 4; ++m) { bf16_t* rowp = P + (size_t)(row0 + ai * HALF + m * 16) * INW + col0;
#pragma unroll
                    for (int bj = 0; bj < 2; ++bj) { const f32x4 v0 = acc[ai][bj][m][0], v1 = acc[ai][bj][m][1];
                        u32x4 w; w.x = cvt_pk_bf16(v0[0], v0[1]); w.y = cvt_pk_bf16(v0[2], v0[3]); w.z = cvt_pk_bf16(v1[0], v1[1]); w.w = cvt_pk_bf16(v1[2], v1[3]);
                        *(u32x4*)(rowp + bj * HALF) = w; } }
        }
    }
};
struct EpiGlu {
    const float* bglu; const bf16_t* P; bf16_t* ACT;
    static __device__ __forceinline__ bool keep(const Unit&) { return false; }
    __device__ __forceinline__ void operator()(f32x4 (&acc)[2][2][4][2], const Unit& u, int wr, int wc, int fr, int fq) const {
        const int row0 = u.pm * BM + wr * 64 + fr, col0 = u.pn * 128 + wc * 32 + 8 * fq;
        float ba[8], bg[8];
        { const f32x4 a0 = *(const f32x4*)(bglu + col0), a1 = *(const f32x4*)(bglu + col0 + 4), g0 = *(const f32x4*)(bglu + 2048 + col0), g1 = *(const f32x4*)(bglu + 2048 + col0 + 4);
#pragma unroll
          for (int j = 0; j < 4; ++j) { ba[j] = a0[j]; ba[4 + j] = a1[j]; bg[j] = g0[j]; bg[4 + j] = g1[j]; } }
#pragma unroll
        for (int ai = 0; ai < 2; ++ai)
#pragma unroll
            for (int m = 0; m < 4; ++m) { const size_t row = (size_t)(row0 + ai * HALF + m * 16);
                const u32x4 zw = *(const u32x4*)(P + row * INW + C_ZS + col0); float z[8]; unpack8(zw, z);
                float o[8];
#pragma unroll
                for (int n = 0; n < 2; ++n)
#pragma unroll
                    for (int j = 0; j < 4; ++j) { const int e = 4 * n + j; const float a = acc[ai][0][m][n][j] + ba[e], g = acc[ai][1][m][n][j] + bg[e]; o[e] = a * sigm(g) * (z[e] * sigm(z[e])); }
                u32x4 w; w.x = cvt_pk_bf16(o[0], o[1]); w.y = cvt_pk_bf16(o[2], o[3]); w.z = cvt_pk_bf16(o[4], o[5]); w.w = cvt_pk_bf16(o[6], o[7]);
                *(u32x4*)(ACT + row * DM + 2048 + col0) = w; }
    }
};
struct EpiMerge {
    const bf16_t* P; bf16_t* O;
    static __device__ __forceinline__ bool keep(const Unit& u) { return u.flag == 0; }
    __device__ __forceinline__ void operator()(f32x4 (&acc)[2][2][4][2], const Unit& u, int wr, int wc, int fr, int fq) const {
        const int row0 = u.pm * BM + wr * 64 + fr, col0 = u.pn * BM + wc * 32 + 8 * fq;
#pragma unroll
        for (int ai = 0; ai < 2; ++ai)
#pragma unroll
            for (int m = 0; m < 4; ++m) { const size_t row = (size_t)(row0 + ai * HALF + m * 16);
#pragma unroll
                for (int bj = 0; bj < 2; ++bj) { const int col = col0 + bj * HALF;
                    const u32x4 sw = *(const u32x4*)(P + row * INW + C_GS + col); float gs[8]; unpack8(sw, gs);
                    if (u.flag == 0) {
                        const u32x4 aw = *(const u32x4*)(P + row * INW + C_GA + col); float ga[8]; unpack8(aw, ga);
#pragma unroll
                        for (int n = 0; n < 2; ++n)
#pragma unroll
                            for (int j = 0; j < 4; ++j) { const int e = 4 * n + j; const float ea = __expf(-fmaxf(ga[e], -30.f)), es = __expf(-fmaxf(gs[e], -30.f)); acc[ai][bj][m][n][j] *= (1.0f + es) / (1.0f + ea); }
                    } else {
                        float o[8];
#pragma unroll
                        for (int n = 0; n < 2; ++n)
#pragma unroll
                            for (int j = 0; j < 4; ++j) { const int e = 4 * n + j; o[e] = acc[ai][bj][m][n][j] / (1.0f + __expf(-fmaxf(gs[e], -30.f))); }
                        u32x4 w; w.x = cvt_pk_bf16(o[0], o[1]); w.y = cvt_pk_bf16(o[2], o[3]); w.z = cvt_pk_bf16(o[4], o[5]); w.w = cvt_pk_bf16(o[6], o[7]);
                        *(u32x4*)(O + row * DM + col) = w;
                    } } }
    }
};
struct EpiOut {
    const float* xp; const float* xs; float* out; float* rowss;
    static __device__ __forceinline__ bool keep(const Unit&) { return false; }
    __device__ __forceinline__ void operator()(f32x4 (&acc)[2][2][4][2], const Unit& u, int wr, int wc, int fr, int fq) const {
        const int row0 = u.pm * BM + wr * 64 + fr, col0 = u.pn * BM + wc * 32 + 8 * fq;
        const float* xb = (u.pm * BM < MP) ? xp : (xs - (size_t)MP * DM);
#pragma unroll
        for (int ai = 0; ai < 2; ++ai)
#pragma unroll
            for (int m = 0; m < 4; ++m) { const size_t row = (size_t)(row0 + ai * HALF + m * 16); float ss = 0.f;
#pragma unroll
                for (int bj = 0; bj < 2; ++bj)
#pragma unroll
                    for (int n = 0; n < 2; ++n) { const size_t off = row * DM + col0 + bj * HALF + 4 * n; const f32x4 xv = *(const f32x4*)(xb + off); const f32x4 o = xv + acc[ai][bj][m][n];
                        *(f32x4*)(out + off) = o; ss += (o[0] * o[0] + o[1] * o[1]) + (o[2] * o[2] + o[3] * o[3]); }
                ss += __shfl_xor(ss, 16); ss += __shfl_xor(ss, 32);
                if (fq == 0) atomicAdd(rowss + row, ss); }
    }
};

template <class Epi, class Sched, bool ALIGN_EPI = true>
__device__ __forceinline__ void gemm_phase(LAS unsigned char* lds, const Gemm g, const Sched& S, const Epi& E) {
    const int tid = threadIdx.x, wid = __builtin_amdgcn_readfirstlane(tid >> 6), lane = tid & 63, wr = wid >> 2, wc = wid & 3, fr = lane & 15, fq = lane >> 4;
    const int K = g.K, nt = K / BK;
    unsigned voffA[2], voffB[2];
#pragma unroll
    for (int i = 0; i < 2; ++i) { int R, C; stage_rc(tid * 16 + i * 8192, R, C); const int Rb = (R & ~31) + perm32(R & 31);
        voffA[i] = (unsigned)(R * g.lda + C) * 2u; voffB[i] = (unsigned)(Rb * g.ldb + C) * 2u; }
    const size_t kstep = (size_t)(BK * 2);
    const size_t hstepA = (size_t)HALF * g.lda * 2, hstepB = (size_t)HALF * g.ldb * 2;
    const unsigned ldsw = (unsigned)wid * 1024u;
    const int aoff = lds_byte(wr * 64 + fr, fq * 8), boff = lds_byte(wc * 32 + fr, fq * 8);
#define PG8_SA(b, h) (((b) * 2 + (h)) * HTB)
#define PG8_SB(b, h) ((4 + (b) * 2 + (h)) * HTB)
#define PG8_STAGE(bufoff, gbase, voff) do { _Pragma("unroll") for (int _i = 0; _i < 2; ++_i) \
        __builtin_amdgcn_global_load_lds((const unsigned*)((const char*)(gbase) + (voff)[_i]), (LAS unsigned*)(lds + (bufoff) + ldsw + _i * 8192), 16, 0, 0); } while (0)
#define PG8_LDA(dst, b, h) do { _Pragma("unroll") for (int m = 0; m < 4; ++m) _Pragma("unroll") for (int k = 0; k < 2; ++k) dst[m][k] = *(const LAS bf16x8*)(lds + PG8_SA(b, h) + aoff + m * 2048 + k * 1024); } while (0)
#define PG8_LDB(dst, b, h) do { _Pragma("unroll") for (int n = 0; n < 2; ++n) _Pragma("unroll") for (int k = 0; k < 2; ++k) dst[n][k] = *(const LAS bf16x8*)(lds + PG8_SB(b, h) + boff + n * 2048 + k * 1024); } while (0)
#define PG8_MMA(ai, bj, At, Bt) do { __builtin_amdgcn_s_setprio(1); _Pragma("unroll") for (int m = 0; m < 4; ++m) _Pragma("unroll") for (int n = 0; n < 2; ++n) _Pragma("unroll") for (int k = 0; k < 2; ++k) \
        acc[ai][bj][m][n] = __builtin_amdgcn_mfma_f32_16x16x32_bf16(Bt[n][k], At[m][k], acc[ai][bj][m][n], 0, 0, 0); __builtin_amdgcn_s_setprio(0); } while (0)
#define PG8_WAIT_V(n) asm volatile("s_waitcnt vmcnt(" #n ")" ::: "memory")
#define PG8_WAIT_L(n) asm volatile("s_waitcnt lgkmcnt(" #n ")" ::: "memory")
#define PG8_BAR __builtin_amdgcn_s_barrier()
#define PG8_SCHED __builtin_amdgcn_sched_barrier(0)
    Unit cur, nxt; int ui = 0;
    if (!S.next(0, cur)) return;
    f32x4 acc[2][2][4][2];
#pragma unroll
    for (int a = 0; a < 2; ++a)
#pragma unroll
        for (int b = 0; b < 2; ++b)
#pragma unroll
            for (int m = 0; m < 4; ++m)
#pragma unroll
                for (int n = 0; n < 2; ++n) acc[a][b][m][n] = (f32x4){0.f, 0.f, 0.f, 0.f};
    bf16x8 At[4][2], B0[2][2], B1[2][2];
    const char* cA = (const char*)g.A + ((size_t)cur.pm * BM * g.lda + cur.acol) * 2; const char* cB = (const char*)g.Bt + (size_t)cur.brow * g.ldb * 2;
    PG8_STAGE(PG8_SB(0, 0), cB, voffB); PG8_STAGE(PG8_SB(0, 1), cB + hstepB, voffB); PG8_STAGE(PG8_SA(0, 0), cA, voffA); PG8_STAGE(PG8_SA(0, 1), cA + hstepA, voffA);
    if (wr == 1) PG8_BAR;
    PG8_WAIT_V(2); PG8_BAR;
    PG8_STAGE(PG8_SB(1, 0), cB + kstep, voffB); PG8_STAGE(PG8_SA(1, 0), cA + kstep, voffA); PG8_STAGE(PG8_SB(1, 1), cB + hstepB + kstep, voffB);
    PG8_WAIT_V(6); PG8_BAR;
    for (;;) {
        const bool has_next = S.next(ui + 1, nxt);
        const char* nA = has_next ? (const char*)g.A + ((size_t)nxt.pm * BM * g.lda + nxt.acol) * 2 : cA; const char* nB = has_next ? (const char*)g.Bt + (size_t)nxt.brow * g.ldb * 2 : cB;
        for (int t = 0; t < nt; t += 2) {
            const bool last = (t == nt - 2);
            const char* a1 = cA + (size_t)(t + 1) * kstep;
            const char* a2 = last ? nA : cA + (size_t)(t + 2) * kstep; const char* b2 = last ? nB : cB + (size_t)(t + 2) * kstep;
            const char* a3 = a2 + kstep; const char* b3 = b2 + kstep;
            PG8_LDB(B0, 0, 0); PG8_LDB(B1, 0, 1); PG8_SCHED; PG8_LDA(At, 0, 0); PG8_STAGE(PG8_SA(1, 1), a1 + hstepA, voffA);
            PG8_WAIT_V(8); PG8_WAIT_L(0); PG8_BAR; PG8_MMA(0, 0, At, B0); PG8_MMA(0, 1, At, B1); PG8_BAR; PG8_SCHED;
            PG8_LDA(At, 0, 1); PG8_STAGE(PG8_SB(0, 0), b2, voffB); PG8_STAGE(PG8_SB(0, 1), b2 + hstepB, voffB); PG8_STAGE(PG8_SA(0, 0), a2, voffA);
            PG8_WAIT_V(8); PG8_WAIT_L(0); PG8_BAR; PG8_MMA(1, 0, At, B0); PG8_MMA(1, 1, At, B1); PG8_BAR; PG8_SCHED;
            PG8_LDB(B0, 1, 0); PG8_LDB(B1, 1, 1); PG8_SCHED; PG8_LDA(At, 1, 0); PG8_STAGE(PG8_SA(0, 1), a2 + hstepA, voffA);
            PG8_WAIT_V(8); PG8_WAIT_L(0); PG8_BAR; PG8_MMA(0, 0, At, B0); PG8_MMA(0, 1, At, B1); PG8_BAR; PG8_SCHED;
            PG8_LDA(At, 1, 1); PG8_STAGE(PG8_SB(1, 0), b3, voffB); PG8_STAGE(PG8_SB(1, 1), b3 + hstepB, voffB); PG8_STAGE(PG8_SA(1, 0), a3, voffA);
            PG8_WAIT_V(8); PG8_WAIT_L(0); PG8_BAR; PG8_MMA(1, 0, At, B0); PG8_MMA(1, 1, At, B1); PG8_BAR; PG8_SCHED;
        }
        if constexpr (ALIGN_EPI) { if (wr == 0) PG8_BAR; }
        E(acc, cur, wr, wc, fr, fq);
        if (!has_next) break;
        if (!Epi::keep(cur)) {
#pragma unroll
            for (int a = 0; a < 2; ++a)
#pragma unroll
                for (int b = 0; b < 2; ++b)
#pragma unroll
                    for (int m = 0; m < 4; ++m)
#pragma unroll
                        for (int n = 0; n < 2; ++n) acc[a][b][m][n] = (f32x4){0.f, 0.f, 0.f, 0.f};
        }
        cur = nxt; cA = nA; cB = nB; ++ui;
        if constexpr (ALIGN_EPI) { if (wr == 1) PG8_BAR; }
    }
    PG8_WAIT_V(0);
    if constexpr (!ALIGN_EPI) { if (wr == 0) PG8_BAR; }
    PG8_BAR;
#undef PG8_SA
#undef PG8_SB
#undef PG8_STAGE
#undef PG8_LDA
#undef PG8_LDB
#undef PG8_MMA
#undef PG8_WAIT_V
#undef PG8_WAIT_L
#undef PG8_BAR
#undef PG8_SCHED
}
}

using pg8::cvt_pk_bf16; using pg8::bf_lo; using pg8::bf_hi; using pg8::sigm;

struct Args { const float* in[23]; float* out; unsigned char* ws; int ph_lo, ph_hi; };
enum { I_XP = 0, I_XS, I_CK, I_CV, I_SRE, I_SIM, I_NG, I_WIN, I_SINK, I_LRE, I_LIM, I_LDT, I_BRE, I_BIM, I_CRE, I_CIM, I_DSK, I_WGLU, I_BGLU, I_WPA, I_WPS, I_WOUT, I_FG };

#define LDS_WAIT() asm volatile("s_waitcnt lgkmcnt(0)" ::: "memory")
__device__ __forceinline__ unsigned f2bf(float f) { unsigned u = __float_as_uint(f); return (u + 0x7fffu + ((u >> 16) & 1u)) >> 16; }
__device__ __forceinline__ unsigned pk2(float lo, float hi) { return f2bf(lo) | (f2bf(hi) << 16); }
__device__ __forceinline__ float wave_sum(float v) {
#pragma unroll
    for (int o = 1; o < 64; o <<= 1) v += __shfl_xor(v, o);
    return v;
}
__device__ __forceinline__ void sincos_acc(double a, float& s, float& c) {
    const double q = rint(a * 0.63661977236758134308);
    double r = fma(-q, 1.57079632679489655800e+00, a); r = fma(-q, 6.12323399573676603587e-17, r);
    const double r2 = r * r;
    double sp = -7.6471637318198164759e-13; sp = fma(sp, r2, 1.6059043836821614599e-10); sp = fma(sp, r2, -2.5052108385441718775e-08); sp = fma(sp, r2, 2.7557319223985890653e-06);
    sp = fma(sp, r2, -1.9841269841269841270e-04); sp = fma(sp, r2, 8.3333333333333333333e-03); sp = fma(sp, r2, -1.6666666666666666667e-01); const double sr = fma(sp * r2, r, r);
    double cp = 4.7794773323873852974e-14; cp = fma(cp, r2, -1.1470745597729724714e-11); cp = fma(cp, r2, 2.0876756987868098979e-09); cp = fma(cp, r2, -2.7557319223985890653e-07);
    cp = fma(cp, r2, 2.4801587301587301587e-05); cp = fma(cp, r2, -1.3888888888888888889e-03); cp = fma(cp, r2, 4.1666666666666666667e-02); cp = fma(cp, r2, -0.5); const double cr = fma(cp, r2, 1.0);
    const int qi = (int)((long long)q & 3);
    const double ss = (qi == 0) ? sr : (qi == 1) ? cr : (qi == 2) ? -sr : -cr;
    const double cc = (qi == 0) ? cr : (qi == 1) ? -sr : (qi == 2) ? -cr : sr;
    s = (float)ss; c = (float)cc;
}

template <class RowMap>
__device__ __forceinline__ void p0_transpose_item(const float* W, int N, bf16_t* WT, int ldt, const RowMap& rm, LAS float* scr, int item, int lane) {
    const int nblk = N / 32, kb = item / nblk, nb = item % nblk, k0 = 64 * kb, n0 = 32 * nb;
#pragma unroll 8
    for (int i = 0; i < 32; ++i) { const int kk = 2 * i + (lane >> 5); scr[kk * 33 + (lane & 31)] = W[(size_t)(k0 + kk) * N + n0 + (lane & 31)]; }
    LDS_WAIT(); asm volatile("" ::: "memory");
    const int c = lane & 7;
#pragma unroll
    for (int j = 0; j < 4; ++j) { const int n = (lane >> 3) + 8 * j; const LAS float* s = scr + (8 * c) * 33 + n;
        u32x4 o; o.x = pk2(s[0 * 33], s[1 * 33]); o.y = pk2(s[2 * 33], s[3 * 33]); o.z = pk2(s[4 * 33], s[5 * 33]); o.w = pk2(s[6 * 33], s[7 * 33]);
        *(u32x4*)(WT + (size_t)rm(n0 + n) * ldt + k0 + 8 * c) = o; }
    LDS_WAIT(); asm volatile("" ::: "memory");
}
struct RmId { __device__ int operator()(int n) const { return n; } };
struct RmGlu { __device__ int operator()(int n) const { const int part = n >> 11, j = n & 2047; return ((j >> 7) << 8) + (part << 7) + (j & 127); } };
struct RmMerge { int half; __device__ int operator()(int n) const { return ((n >> 8) << 9) + (half << 8) + (n & 255); } };

__device__ __forceinline__ void p0_prologue(const Args& a, LAS unsigned char* lds, int tid, int lane, int wave, int G) {
    unsigned char* ws = a.ws;
    LAS float* scr = (LAS float*)(lds + wave * 16384);
    const int gw = blockIdx.x * NWAVES + wave, NGW = G * NWAVES;
    constexpr int I_1 = 64 * (INW / 32), I_2 = 32 * 128, I_3 = 32 * 128, I_4 = 32 * 128, I_5 = 64 * 128;
    constexpr int NITEMS = I_1 + I_2 + I_3 + I_4 + I_5;
    for (int it = gw; it < NITEMS; it += NGW) {
        int r = it;
        if (r < I_1) { p0_transpose_item(a.in[I_WIN], INW, (bf16_t*)(ws + WS_WIN), 4096, RmId{}, scr, r, lane); continue; } r -= I_1;
        if (r < I_2) { p0_transpose_item(a.in[I_WGLU], 4096, (bf16_t*)(ws + WS_WGLU), 2048, RmGlu{}, scr, r, lane); continue; } r -= I_2;
        if (r < I_3) { p0_transpose_item(a.in[I_WPA], 4096, (bf16_t*)(ws + WS_WM), 2048, RmMerge{0}, scr, r, lane); continue; } r -= I_3;
        if (r < I_4) { p0_transpose_item(a.in[I_WPS], 4096, (bf16_t*)(ws + WS_WM), 2048, RmMerge{1}, scr, r, lane); continue; } r -= I_4;
        p0_transpose_item(a.in[I_WOUT], 4096, (bf16_t*)(ws + WS_WOUT), 4096, RmId{}, scr, r, lane);
    }
    const float* ng = a.in[I_NG];
    for (int m = gw; m < MT; m += NGW) {
        const float* xrow = (m < MP) ? a.in[I_XP] + (size_t)m * DM : a.in[I_XS] + (size_t)(m - MP) * DM;
        const f32x4* xr = (const f32x4*)xrow + lane;
        f32x4 v[16]; float s = 0.f;
#pragma unroll
        for (int j = 0; j < 16; ++j) { v[j] = xr[64 * j]; s += (v[j].x * v[j].x + v[j].y * v[j].y) + (v[j].z * v[j].z + v[j].w * v[j].w); }
        const float rs = 1.0f / sqrtf(wave_sum(s) * (1.0f / DM) + EPS);
        u32x2* o8 = (u32x2*)((bf16_t*)(ws + WS_XN) + (size_t)m * DM) + lane;
#pragma unroll
        for (int j = 0; j < 16; ++j) { const f32x4 gg = *((const f32x4*)ng + lane + 64 * j); u32x2 w; w.x = pk2(v[j].x * rs * gg.x, v[j].y * rs * gg.y); w.y = pk2(v[j].z * rs * gg.z, v[j].w * rs * gg.w); o8[64 * j] = w; }
    }
    const int gt = blockIdx.x * (NWAVES * 64) + tid, NGT = G * NWAVES * 64;
    for (int e = gt; e < NG * SD; e += NGT) {
        const int g = e >> 6;
        const float lr = fminf(a.in[I_LRE][e], -1e-4f), li = a.in[I_LIM][e], dt = expf(a.in[I_LDT][g]);
        const float mag = expf(lr * dt), ang = li * dt; float sn, cs; sincos_acc((double)ang, sn, cs);
        const float are = mag * cs, aim = mag * sn;
        const float den = lr * lr + li * li, nr = are - 1.0f;
        const float fre = (nr * lr + aim * li) / den, fim = (aim * lr - nr * li) / den;
        ((float*)(ws + WS_ARE))[e] = are; ((float*)(ws + WS_AIM))[e] = aim;
        float s64, c64; sincos_acc(64.0 * (double)ang, s64, c64); const float m64 = expf(64.0f * (lr * dt));
        ((float*)(ws + WS_A64R))[e] = m64 * c64; ((float*)(ws + WS_A64I))[e] = m64 * s64;
        const float* br = a.in[I_BRE] + (size_t)e * 16; const float* bi = a.in[I_BIM] + (size_t)e * 16;
        float* obr = (float*)(ws + WS_BBR) + (size_t)e * 16; float* obi = (float*)(ws + WS_BBI) + (size_t)e * 16;
#pragma unroll
        for (int i = 0; i < 16; ++i) { const float b_r = br[i], b_i = bi[i]; obr[i] = fre * b_r - fim * b_i; obi[i] = fre * b_i + fim * b_r; }
    }
    for (int e = gt; e < 4096 * 32; e += NGT) {
        const int pos = e >> 5, j = e & 31;
        const float invf = (float)exp2(-(double)j * (13.287712379549449 / 32.0));
        const float ang = (float)pos * invf; float sn, cs; sincos_acc((double)ang, sn, cs);
        ((float*)(ws + WS_ROPC))[e] = cs; ((float*)(ws + WS_ROPS))[e] = sn;
    }
    for (int e = gt; e < MT; e += NGT) ((float*)(ws + WS_ROWSS))[e] = 0.f;
}

constexpr int KS_STRIDE = 72, VT_STRIDE = 200, VT_OFF = 192 * KS_STRIDE * 2;
__device__ __forceinline__ void attn_item(const Args& a, LAS unsigned char* lds, int item, int tid, int lane, int wave) {
    unsigned char* ws = a.ws;
    const bf16_t* P = (const bf16_t*)(ws + WS_PROJ); const float* KV = (const float*)(ws + WS_KV);
    const float* RC = (const float*)(ws + WS_ROPC); const float* RS = (const float*)(ws + WS_ROPS);
    bf16_t* ACT = (bf16_t*)(ws + WS_ACT);
    int s, c, g; const bool samp = item >= NB * NCH * NKV;
    if (!samp) { g = item & 3; c = (item >> 2) & 63; s = item >> 8; } else { const int r = item - NB * NCH * NKV; g = r & 3; c = 0; s = r >> 2; }
    const int m0 = samp ? MP + s * 64 : s * SEQ + c * 64;
    const int pos0 = samp ? PAST : c * 64;
    LAS bf16_t* Ks = (LAS bf16_t*)lds; LAS bf16_t* Vt = (LAS bf16_t*)(lds + VT_OFF);
    __syncthreads();
#pragma unroll
    for (int r = 0; r < 3; ++r) {
        const int idx = tid + 512 * r, kk = idx >> 3, d0 = (idx & 7) * 4;
        f32x4 k1 = {0.f, 0.f, 0.f, 0.f}, k2 = {0.f, 0.f, 0.f, 0.f};
        if (samp && kk < 128) {
            const float* src = a.in[I_CK] + ((size_t)(s * 128 + kk) * 4 + g) * 64 + d0; k1 = *(const f32x4*)src; k2 = *(const f32x4*)(src + 32);
        } else {
            const int tok = samp ? (kk - 128) : (c - 2) * 64 + kk;
            if (tok >= 0) {
                const int m = samp ? MP + s * 64 + tok : s * SEQ + tok; const int pos = samp ? PAST + tok : tok;
                const float* src = KV + (size_t)m * 512 + g * 64 + d0; const f32x4 x1 = *(const f32x4*)src, x2 = *(const f32x4*)(src + 32);
                const f32x4 cs = *(const f32x4*)(RC + pos * 32 + d0), sn = *(const f32x4*)(RS + pos * 32 + d0);
                k1 = x1 * cs - x2 * sn; k2 = x2 * cs + x1 * sn;
                if (kk >= 128) {
                    if (samp) { float* o = a.out + O_KS + ((size_t)(s * 64 + tok) * 4 + g) * 64 + d0; *(f32x4*)o = k1; *(f32x4*)(o + 32) = k2; }
                    else if (c >= NCH - 2) { float* o = a.out + O_KP + ((size_t)(s * 128 + (tok - (SEQ - 128))) * 4 + g) * 64 + d0; *(f32x4*)o = k1; *(f32x4*)(o + 32) = k2; }
                }
            }
        }
        u32x2 w1, w2; w1.x = pk2(k1.x, k1.y); w1.y = pk2(k1.z, k1.w); w2.x = pk2(k2.x, k2.y); w2.y = pk2(k2.z, k2.w);
        *(LAS u32x2*)(Ks + kk * KS_STRIDE + d0) = w1; *(LAS u32x2*)(Ks + kk * KS_STRIDE + 32 + d0) = w2;
    }
#pragma unroll
    for (int r = 0; r < 6; ++r) {
        const int idx = tid + 512 * r, kk = idx >> 4, d0 = (idx & 15) * 4;
        f32x4 v = {0.f, 0.f, 0.f, 0.f};
        if (samp && kk < 128) { v = *(const f32x4*)(a.in[I_CV] + ((size_t)(s * 128 + kk) * 4 + g) * 64 + d0); }
        else {
            const int tok = samp ? (kk - 128) : (c - 2) * 64 + kk;
            if (tok >= 0) {
                const int m = samp ? MP + s * 64 + tok : s * SEQ + tok;
                v = *(const f32x4*)(KV + (size_t)m * 512 + 256 + g * 64 + d0);
                if (kk >= 128) {
                    if (samp) *(f32x4*)(a.out + O_VS + ((size_t)(s * 64 + tok) * 4 + g) * 64 + d0) = v;
                    else if (c >= NCH - 2) *(f32x4*)(a.out + O_VP + ((size_t)(s * 128 + (tok - (SEQ - 128))) * 4 + g) * 64 + d0) = v;
                }
            }
        }
        Vt[(d0 + 0) * VT_STRIDE + kk] = (bf16_t)f2bf(v.x); Vt[(d0 + 1) * VT_STRIDE + kk] = (bf16_t)f2bf(v.y);
        Vt[(d0 + 2) * VT_STRIDE + kk] = (bf16_t)f2bf(v.z); Vt[(d0 + 3) * VT_STRIDE + kk] = (bf16_t)f2bf(v.w);
    }
    __syncthreads();
    const int fr = lane & 15, fq = lane >> 4, h = g * 8 + wave;
    const float sink = a.in[I_SINK][h];
    const int jb_min = (!samp && c < 2) ? (2 - c) * 4 : 0;
    for (int tb = 0; tb < 4; ++tb) {
        const int tok = tb * 16 + fr; const size_t m = (size_t)(m0 + tok); const int pos = pos0 + tok;
        const bf16_t* qp = P + m * INW + C_Q + h * 64 + fq * 8;
        const u32x4 qa = *(const u32x4*)qp, qb = *(const u32x4*)(qp + 32);
        float q1[8], q2[8]; pg8::unpack8(qa, q1); pg8::unpack8(qb, q2);
        const f32x4 c0 = *(const f32x4*)(RC + pos * 32 + fq * 8), c1 = *(const f32x4*)(RC + pos * 32 + fq * 8 + 4);
        const f32x4 s0 = *(const f32x4*)(RS + pos * 32 + fq * 8), s1 = *(const f32x4*)(RS + pos * 32 + fq * 8 + 4);
        float r1[8], r2[8];
#pragma unroll
        for (int j = 0; j < 8; ++j) { const float cs = j < 4 ? c0[j & 3] : c1[j & 3], sn = j < 4 ? s0[j & 3] : s1[j & 3]; r1[j] = (q1[j] * cs - q2[j] * sn) * 0.125f; r2[j] = (q2[j] * cs + q1[j] * sn) * 0.125f; }
        u32x4 w0, w1; w0.x = cvt_pk_bf16(r1[0], r1[1]); w0.y = cvt_pk_bf16(r1[2], r1[3]); w0.z = cvt_pk_bf16(r1[4], r1[5]); w0.w = cvt_pk_bf16(r1[6], r1[7]);
        w1.x = cvt_pk_bf16(r2[0], r2[1]); w1.y = cvt_pk_bf16(r2[2], r2[3]); w1.z = cvt_pk_bf16(r2[4], r2[5]); w1.w = cvt_pk_bf16(r2[6], r2[7]);
        const bf16x8 qf0 = __builtin_bit_cast(bf16x8, w0), qf1 = __builtin_bit_cast(bf16x8, w1);
        f32x4 sc[12];
#pragma unroll
        for (int jb = 0; jb < 12; ++jb) {
            const LAS bf16_t* kp = Ks + (jb * 16 + fr) * KS_STRIDE + fq * 8;
            const bf16x8 kf0 = *(const LAS bf16x8*)kp, kf1 = *(const LAS bf16x8*)(kp + 32);
            f32x4 z = {0.f, 0.f, 0.f, 0.f};
            z = __builtin_amdgcn_mfma_f32_16x16x32_bf16(kf0, qf0, z, 0, 0, 0);
            sc[jb] = __builtin_amdgcn_mfma_f32_16x16x32_bf16(kf1, qf1, z, 0, 0, 0);
        }
        float mx = sink;
#pragma unroll
        for (int jb = 0; jb < 12; ++jb) if (jb >= jb_min) { mx = fmaxf(mx, fmaxf(fmaxf(sc[jb][0], sc[jb][1]), fmaxf(sc[jb][2], sc[jb][3]))); }
        mx = fmaxf(mx, __shfl_xor(mx, 16)); mx = fmaxf(mx, __shfl_xor(mx, 32));
        float l = 0.f;
#pragma unroll
        for (int jb = 0; jb < 12; ++jb) {
#pragma unroll
            for (int j = 0; j < 4; ++j) { const float p = (jb >= jb_min) ? __expf(sc[jb][j] - mx) : 0.f; sc[jb][j] = p; l += p; } }
        l += __shfl_xor(l, 16); l += __shfl_xor(l, 32);
        l += __expf(sink - mx);
        const float inv = 1.0f / l;
        bf16x8 pa[6];
#pragma unroll
        for (int i = 0; i < 6; ++i) { u32x4 w; w.x = cvt_pk_bf16(sc[2 * i][0] * inv, sc[2 * i][1] * inv); w.y = cvt_pk_bf16(sc[2 * i][2] * inv, sc[2 * i][3] * inv);
            w.z = cvt_pk_bf16(sc[2 * i + 1][0] * inv, sc[2 * i + 1][1] * inv); w.w = cvt_pk_bf16(sc[2 * i + 1][2] * inv, sc[2 * i + 1][3] * inv); pa[i] = __builtin_bit_cast(bf16x8, w); }
#pragma unroll
        for (int db = 0; db < 4; ++db) {
            f32x4 o = {0.f, 0.f, 0.f, 0.f};
            const LAS bf16_t* vp = Vt + (db * 16 + fr) * VT_STRIDE + fq * 4;
#pragma unroll
            for (int i = 0; i < 6; ++i) { const u32x2 va = *(const LAS u32x2*)(vp + (2 * i) * 16), vb = *(const LAS u32x2*)(vp + (2 * i + 1) * 16);
                u32x4 w; w.x = va.x; w.y = va.y; w.z = vb.x; w.w = vb.y;
                o = __builtin_amdgcn_mfma_f32_16x16x32_bf16(pa[i], __builtin_bit_cast(bf16x8, w), o, 0, 0, 0); }
#pragma unroll
            for (int j = 0; j < 4; ++j) { const size_t mm = (size_t)(m0 + tb * 16 + fq * 4 + j); const int col = h * 64 + db * 16 + fr;
                const float z = bf_lo((unsigned)P[mm * INW + C_ZA + col]); ACT[mm * DM + col] = (bf16_t)f2bf(o[j] * z * sigm(z)); }
        }
    }
}

constexpr int HB_STRIDE = 136;
template <bool FULL>
__device__ __forceinline__ void ssm_item(const Args& a, LAS unsigned char* wl, int s, int c, int g, int lane) {
    unsigned char* ws = a.ws;
    const bf16_t* P = (const bf16_t*)(ws + WS_PROJ);
    const bool samp = s >= NB; const int sb = s - NB;
    const int m0 = samp ? MP + sb * 64 : s * SEQ + c * 64;
    LAS float* uf = (LAS float*)wl;
    LAS bf16_t* hb = (LAS bf16_t*)(wl + 4096);
#pragma unroll
    for (int r = 0; r < 8; ++r) { const int t = r * 8 + (lane >> 3), d = lane & 7;
        const unsigned w = *(const unsigned*)(P + (size_t)(m0 + t) * INW + C_U + g * 16 + d * 2);
        f32x2 v; v.x = bf_lo(w); v.y = bf_hi(w); *(LAS f32x2*)(uf + t * 16 + d * 2) = v; }
    const int e = g * 64 + lane;
    const float are = ((const float*)(ws + WS_ARE))[e], aim = ((const float*)(ws + WS_AIM))[e];
    float bbr[16], bbi[16];
    { const f32x4* pr = (const f32x4*)((const float*)(ws + WS_BBR) + (size_t)e * 16); const f32x4* pi = (const f32x4*)((const float*)(ws + WS_BBI) + (size_t)e * 16);
#pragma unroll
      for (int q = 0; q < 4; ++q) { const f32x4 x = pr[q], y = pi[q];
#pragma unroll
          for (int j = 0; j < 4; ++j) { bbr[q * 4 + j] = x[j]; bbi[q * 4 + j] = y[j]; } } }
    const int fr = lane & 15, fq = lane >> 4;
    bf16x8 cf[4]; f32x4 dsk = {0.f, 0.f, 0.f, 0.f};
    float hr = 0.f, hi = 0.f;
    if constexpr (FULL) {
#pragma unroll
        for (int kb = 0; kb < 4; ++kb) { const float* src = ((kb < 2) ? a.in[I_CRE] : a.in[I_CIM]) + (size_t)(g * 16 + fr) * 64 + (kb & 1) * 32 + fq * 8;
            const f32x4 x = *(const f32x4*)src, y = *(const f32x4*)(src + 4); const float sg = (kb < 2) ? 1.f : -1.f;
            u32x4 w; w.x = pk2(sg * x[0], sg * x[1]); w.y = pk2(sg * x[2], sg * x[3]); w.z = pk2(sg * y[0], sg * y[1]); w.w = pk2(sg * y[2], sg * y[3]); cf[kb] = __builtin_bit_cast(bf16x8, w); }
        dsk = *(const f32x4*)(a.in[I_DSK] + g * 16 + fq * 4);
        if (samp) { hr = a.in[I_SRE][(size_t)(sb * NG + g) * 64 + lane]; hi = a.in[I_SIM][(size_t)(sb * NG + g) * 64 + lane]; }
        else {
            const float a64r = ((const float*)(ws + WS_A64R))[e], a64i = ((const float*)(ws + WS_A64I))[e];
            const float* E = (const float*)(ws + WS_E) + ((size_t)(s * NCH) * NG + g) * 128 + lane;
            for (int j = 0; j < c; ++j) { const float er = E[(size_t)j * NG * 128], ei = E[(size_t)j * NG * 128 + 64];
                const float nr = a64r * hr - a64i * hi + er, ni = a64r * hi + a64i * hr + ei; hr = nr; hi = ni; }
        }
    }
    LDS_WAIT(); asm volatile("" ::: "memory");
    for (int tb = 0; tb < 4; ++tb) {
#pragma unroll
        for (int tt = 0; tt < 16; ++tt) {
            const LAS f32x4* up = (const LAS f32x4*)(uf + (tb * 16 + tt) * 16);
            const f32x4 u0 = up[0], u1 = up[1], u2 = up[2], u3 = up[3];
            float xr = 0.f, xi = 0.f;
#pragma unroll
            for (int j = 0; j < 4; ++j) { xr = fmaf(bbr[j], u0[j], xr); xi = fmaf(bbi[j], u0[j], xi); }
#pragma unroll
            for (int j = 0; j < 4; ++j) { xr = fmaf(bbr[4 + j], u1[j], xr); xi = fmaf(bbi[4 + j], u1[j], xi); }
#pragma unroll
            for (int j = 0; j < 4; ++j) { xr = fmaf(bbr[8 + j], u2[j], xr); xi = fmaf(bbi[8 + j], u2[j], xi); }
#pragma unroll
            for (int j = 0; j < 4; ++j) { xr = fmaf(bbr[12 + j], u3[j], xr); xi = fmaf(bbi[12 + j], u3[j], xi); }
            const float nr = fmaf(are, hr, fmaf(-aim, hi, xr)), ni = fmaf(are, hi, fmaf(aim, hr, xi)); hr = nr; hi = ni;
            if constexpr (FULL) { hb[tt * HB_STRIDE + lane] = (bf16_t)f2bf(hr); hb[tt * HB_STRIDE + 64 + lane] = (bf16_t)f2bf(hi); }
        }
        if constexpr (FULL) {
            LDS_WAIT(); asm volatile("" ::: "memory");
            f32x4 y = {0.f, 0.f, 0.f, 0.f};
#pragma unroll
            for (int kb = 0; kb < 4; ++kb) { const bf16x8 hf = *(const LAS bf16x8*)(hb + fr * HB_STRIDE + kb * 32 + fq * 8); y = __builtin_amdgcn_mfma_f32_16x16x32_bf16(cf[kb], hf, y, 0, 0, 0); }
            const f32x4 uu = *(const LAS f32x4*)(uf + (tb * 16 + fr) * 16 + fq * 4);
            u32x2 w; w.x = cvt_pk_bf16(y[0] + dsk[0] * uu[0], y[1] + dsk[1] * uu[1]); w.y = cvt_pk_bf16(y[2] + dsk[2] * uu[2], y[3] + dsk[3] * uu[3]);
            *(u32x2*)((bf16_t*)(ws + WS_YSSM) + (size_t)(m0 + tb * 16 + fr) * SW + g * 16 + fq * 4) = w;
            LDS_WAIT(); asm volatile("" ::: "memory");
        }
    }
    if constexpr (!FULL) { float* E = (float*)(ws + WS_E) + ((size_t)(s * NCH + c) * NG + g) * 128 + lane; E[0] = hr; E[64] = hi; }
    else {
        if (samp) { a.out[O_HRS + (size_t)(sb * NG + g) * 64 + lane] = hr; a.out[O_HIS + (size_t)(sb * NG + g) * 64 + lane] = hi; }
        else if (c == NCH - 1) { a.out[O_HRP + (size_t)(s * NG + g) * 64 + lane] = hr; a.out[O_HIP + (size_t)(s * NG + g) * 64 + lane] = hi; }
    }
    LDS_WAIT(); asm volatile("" ::: "memory");
}

__global__ void __launch_bounds__(NWAVES * 64, 2) fwd_kernel(Args args) {
    extern __shared__ __attribute__((aligned(16))) unsigned char lds_raw[];
    LAS unsigned char* lds = (LAS unsigned char*)lds_raw;
    const int tid = threadIdx.x, lane = tid & 63, wave = __builtin_amdgcn_readfirstlane(tid >> 6);
    const int G = gridDim.x;
    unsigned char* ws = args.ws;
    const int lo = args.ph_lo, hi = args.ph_hi;
#define IN(k) (lo <= (k) && (k) < hi)
#define SEAM(k) do { if (IN(k) && IN((k) + 1)) cg::this_grid().sync(); } while (0)

    if (IN(0)) { p0_prologue(args, lds, tid, lane, wave, G); }
    SEAM(0);
    if (IN(1)) {
        pg8::Gemm g{(const bf16_t*)(ws + WS_XN), (const bf16_t*)(ws + WS_WIN), DM, DM, DM}; pg8::StaticOrder S; S.init(MT, INW, G, (int)blockIdx.x);
        pg8::EpiProj E{(bf16_t*)(ws + WS_PROJ), (float*)(ws + WS_KV)};
        pg8::gemm_phase<pg8::EpiProj, pg8::StaticOrder>(lds, g, S, E);
    }
    SEAM(1);
    if (IN(2)) {
        constexpr int NATT = NB * NCH * NKV + DB * NKV;
        for (int it = blockIdx.x; it < NATT; it += G) attn_item(args, lds, it, tid, lane, wave);
        __syncthreads();
        const int gw = blockIdx.x * NWAVES + wave, NGW = G * NWAVES;
        for (int it = gw; it < NB * NCH * NG; it += NGW) { const int g = it & 127, c = (it >> 7) & 63, s = it >> 13; ssm_item<false>(args, lds + wave * 16384, s, c, g, lane); }
    }
    SEAM(2);
    if (IN(3)) {
        const int gw = blockIdx.x * NWAVES + wave, NGW = G * NWAVES;
        constexpr int NI = (NB * NCH + DB) * NG;
        for (int it = gw; it < NI; it += NGW) { const int g = it & 127, ch = it >> 7; int s, c; if (ch < NB * NCH) { s = ch >> 6; c = ch & 63; } else { s = NB + (ch - NB * NCH); c = 0; }
            ssm_item<true>(args, lds + wave * 16384, s, c, g, lane); }
    }
    SEAM(3);
    if (IN(4)) {
        pg8::Gemm g{(const bf16_t*)(ws + WS_YSSM), (const bf16_t*)(ws + WS_WGLU), SW, SW, SW}; pg8::StaticOrder S; S.init(MT, 4096, G, (int)blockIdx.x);
        pg8::EpiGlu E{args.in[I_BGLU], (const bf16_t*)(ws + WS_PROJ), (bf16_t*)(ws + WS_ACT)};
        pg8::gemm_phase<pg8::EpiGlu, pg8::StaticOrder>(lds, g, S, E);
    }
    SEAM(4);
    if (IN(5)) {
        pg8::Gemm g{(const bf16_t*)(ws + WS_ACT), (const bf16_t*)(ws + WS_WM), DM, 2048, 2048}; pg8::MergeOrder S; S.S.init(MT, 4096, G, (int)blockIdx.x);
        pg8::EpiMerge E{(const bf16_t*)(ws + WS_PROJ), (bf16_t*)(ws + WS_XN)};
        pg8::gemm_phase<pg8::EpiMerge, pg8::MergeOrder>(lds, g, S, E);
    }
    SEAM(5);
    if (IN(6)) {
        pg8::Gemm g{(const bf16_t*)(ws + WS_XN), (const bf16_t*)(ws + WS_WOUT), DM, DM, DM}; pg8::StaticOrder S; S.init(MT, 4096, G, (int)blockIdx.x);
        pg8::EpiOut E{args.in[I_XP], args.in[I_XS], args.out + O_Y, (float*)(ws + WS_ROWSS)};
        pg8::gemm_phase<pg8::EpiOut, pg8::StaticOrder>(lds, g, S, E);
    }
    SEAM(6);
    if (IN(7)) {
        const int gw = blockIdx.x * NWAVES + wave, NGW = G * NWAVES;
        const float* fg = args.in[I_FG]; const float* rss = (const float*)(ws + WS_ROWSS);
        for (int m = gw; m < MT; m += NGW) {
            const float rs = 1.0f / sqrtf(rss[m] * (1.0f / DM) + EPS);
            f32x4* row = (f32x4*)(args.out + O_Y + (size_t)m * DM) + lane;
#pragma unroll
            for (int j = 0; j < 16; ++j) { const f32x4 gg = *((const f32x4*)fg + lane + 64 * j); f32x4 v = row[64 * j]; v = v * rs * gg; row[64 * j] = v; }
        }
    }
#undef IN
#undef SEAM
}

extern "C" void kernel_launch(void* const* d_in, const int* in_sizes, int n_in, void* d_out, int out_size, void* d_ws, size_t ws_size, hipStream_t stream) {
    static int grid = 0;
    if (grid == 0) {
        if (n_in != 23 || (size_t)out_size != O_END || ws_size < WS_END) { fprintf(stderr, "kernel_launch: unexpected shapes: n_in %d out %d (want %zu) ws %zu (want >= %zu)\n", n_in, out_size, (size_t)O_END, ws_size, (size_t)WS_END); grid = -1; return; }
        int dev = 0, cus = 0, per_cu = 0;
        hipGetDevice(&dev); hipDeviceGetAttribute(&cus, hipDeviceAttributeMultiprocessorCount, dev);
        if (hipFuncSetAttribute((const void*)fwd_kernel, hipFuncAttributeMaxDynamicSharedMemorySize, LDS_BYTES) != hipSuccess) { fprintf(stderr, "kernel_launch: hipFuncSetAttribute failed\n"); grid = -1; return; }
        hipOccupancyMaxActiveBlocksPerMultiprocessor(&per_cu, (const void*)fwd_kernel, NWAVES * 64, LDS_BYTES);
        if (per_cu < 1) { fprintf(stderr, "kernel_launch: occupancy query says %d blocks per CU\n", per_cu); per_cu = 1; }
        (void)hipGetLastError();
        grid = cus;
    }
    if (grid < 0) return;
    Args a{};
    for (int i = 0; i < 23; ++i) a.in[i] = (const float*)d_in[i];
    a.out = (float*)d_out; a.ws = (unsigned char*)d_ws;
#if MK_MULTI
    for (int ph = 0; ph < 8; ++ph) { a.ph_lo = ph; a.ph_hi = ph + 1; hipLaunchKernelGGL(fwd_kernel, dim3(grid), dim3(NWAVES * 64), LDS_BYTES, stream, a); }
#else
    a.ph_lo = 0; a.ph_hi = 8;
    void* kargs[] = {&a};
    hipError_t e = hipLaunchCooperativeKernel((const void*)fwd_kernel, dim3(grid), dim3(NWAVES * 64), kargs, LDS_BYTES, stream);
    if (e != hipSuccess) fprintf(stderr, "kernel_launch: cooperative launch failed: %s (grid %d)\n", hipGetErrorString(e), grid);
#endif
}
```

```cpp
#include <hip/hip_runtime.h>
#include <hip/hip_cooperative_groups.h>
#include <cstdio>
#include <cstdint>
namespace cg = cooperative_groups;

#ifndef MK_MULTI
#define MK_MULTI 0
#endif

#ifndef PROBE_DBL
#define PROBE_DBL 0
#endif
#define LAS __attribute__((address_space(3)))
typedef unsigned short bf16_t;
typedef short bf16x8 __attribute__((ext_vector_type(8)));
typedef float f32x4 __attribute__((ext_vector_type(4)));
typedef float f32x2 __attribute__((ext_vector_type(2)));
typedef unsigned u32x4 __attribute__((ext_vector_type(4)));
typedef unsigned u32x2 __attribute__((ext_vector_type(2)));

constexpr int DM = 4096, NB = 2, SEQ = 4096, DB = 8, DS = 64, PAST = 1024;
constexpr int MP = NB * SEQ, MS = DB * DS, MT = MP + MS;
constexpr int HD = 64, AW = 2048, NQH = 32, NKV = 4, KVW = 256, SW = 2048, NG = 128, SD = 64;
constexpr int INW = 16896;
constexpr int C_Q = 0, C_K = 2048, C_V = 2304, C_ZA = 2560, C_U = 4608, C_ZS = 6656, C_GA = 8704, C_GS = 12800;
constexpr int NCH = SEQ / 64;
constexpr float EPS = 1e-5f;

constexpr size_t MiB = 1u << 20;
constexpr size_t WS_ROWSS = 0;
constexpr size_t WS_ARE = 1 * MiB, WS_AIM = WS_ARE + 32768, WS_A64R = WS_AIM + 32768, WS_A64I = WS_A64R + 32768;
constexpr size_t WS_BBR = 2 * MiB, WS_BBI = 3 * MiB;
constexpr size_t WS_ROPC = 4 * MiB, WS_ROPS = WS_ROPC + 512 * 1024;
constexpr size_t WS_E = 6 * MiB;
constexpr size_t WS_WIN = 16 * MiB;
constexpr size_t WS_WGLU = 148 * MiB;
constexpr size_t WS_WM = 164 * MiB;
constexpr size_t WS_WOUT = 196 * MiB;
constexpr size_t WS_XN = 228 * MiB;
constexpr size_t WS_PROJ = 296 * MiB;
constexpr size_t WS_KV = 577 * MiB;
constexpr size_t WS_ACT = 594 * MiB;
constexpr size_t WS_YSSM = 662 * MiB;
constexpr size_t WS_END = 696 * MiB;

constexpr size_t O_Y = 0;
constexpr size_t O_KP = (size_t)MT * DM;
constexpr size_t O_VP = O_KP + 2 * 128 * 256;
constexpr size_t O_HRP = O_VP + 2 * 128 * 256;
constexpr size_t O_HIP = O_HRP + 2 * 128 * 64;
constexpr size_t O_KS = O_HIP + 2 * 128 * 64;
constexpr size_t O_VS = O_KS + 8 * 64 * 256;
constexpr size_t O_HRS = O_VS + 8 * 64 * 256;
constexpr size_t O_HIS = O_HRS + 8 * 128 * 64;
constexpr size_t O_END = O_HIS + 8 * 128 * 64;

constexpr int NWAVES = 8;
constexpr int LDS_BYTES = 147456;

namespace pg8 {
constexpr int BM = 256, BK = 64, HALF = 128, HTB = HALF * BK * 2, STAGE_BYTES = 8 * HTB, NXCD = 8, WGM = 8;
__host__ __device__ __forceinline__ int lds_byte(int r, int c) { const int st = (r >> 4) * 2 + (c >> 5), rr = r & 15, cc = c & 31, ob = rr * 64 + cc * 2; return st * 1024 + (ob ^ (((ob >> 9) & 1) << 5)); }
__host__ __device__ __forceinline__ void stage_rc(int b, int& R, int& C) { const int st = b / 1024, sb = b % 1024, swz = sb ^ (((sb >> 9) & 1) << 5); R = (st >> 1) * 16 + swz / 64; C = (st & 1) * 32 + (swz % 64) / 2; }
__host__ __device__ __forceinline__ int perm32(int rho) { const int n = rho >> 4, i = rho & 15; return 8 * (i >> 2) + 4 * n + (i & 3); }

struct Unit { int pm, pn, acol, brow, flag; };
struct Gemm { const bf16_t* A; const bf16_t* Bt; int lda, ldb, K; };

struct StaticOrder {
    int nM, nN, nwg, G, c;
    __device__ void init(int M, int N, int G_, int c_) { nM = M / BM; nN = N / BM; nwg = nM * nN; G = G_; c = c_; }
    __device__ bool tile(int i, int& pm, int& pn) const {
        const long L = (long)i * G + c; if (L >= nwg) return false;
        int wgid = (int)L; { const int q = nwg / NXCD, r = nwg % NXCD, xcd = wgid % NXCD, off = wgid / NXCD; wgid = (xcd < r ? xcd * (q + 1) : r * (q + 1) + (xcd - r) * q) + off; }
        const int nig = WGM * nN, gid = wgid / nig, fm = gid * WGM, gsz = (nM - fm) < WGM ? (nM - fm) : WGM;
        pm = fm + ((wgid % nig) % gsz); pn = (wgid % nig) / gsz; return true;
    }
    __device__ bool next(int i, Unit& u) const { if (!tile(i, u.pm, u.pn)) return false; u.acol = 0; u.brow = u.pn * BM; u.flag = 0; return true; }
};
struct MergeOrder {
    StaticOrder S;
    __device__ bool next(int i, Unit& u) const { if (!S.tile(i >> 1, u.pm, u.pn)) return false; const int h = i & 1; u.acol = h * 2048; u.brow = u.pn * 512 + h * 256; u.flag = h; return true; }
};

__device__ __forceinline__ unsigned cvt_pk_bf16(float lo, float hi) { unsigned r; asm volatile("v_cvt_pk_bf16_f32 %0, %1, %2" : "=v"(r) : "v"(lo), "v"(hi)); return r; }
__device__ __forceinline__ float bf_lo(unsigned w) { return __uint_as_float(w << 16); }
__device__ __forceinline__ float bf_hi(unsigned w) { return __uint_as_float(w & 0xffff0000u); }
__device__ __forceinline__ float sigm(float x) { return 1.0f / (1.0f + __expf(-x)); }
__device__ __forceinline__ void unpack8(const u32x4 w, float* f) { f[0] = bf_lo(w.x); f[1] = bf_hi(w.x); f[2] = bf_lo(w.y); f[3] = bf_hi(w.y); f[4] = bf_lo(w.z); f[5] = bf_hi(w.z); f[6] = bf_lo(w.w); f[7] = bf_hi(w.w); }

struct EpiProj {
    bf16_t* P; float* KV;
    static __device__ __forceinline__ bool keep(const Unit&) { return false; }
    __device__ __forceinline__ void operator()(f32x4 (&acc)[2][2][4][2], const Unit& u, int wr, int wc, int fr, int fq) const {
        const int row0 = u.pm * BM + wr * 64 + fr;
        if (u.pn == 8 || u.pn == 9) {
            const int col0 = (u.pn - 8) * 256 + wc * 32 + 8 * fq;
#pragma unroll
            for (int ai = 0; ai < 2; ++ai)
#pragma unroll
                for (int m = 0; m < 4; ++m) { float* rowp = KV + (size_t)(row0 + ai * HALF + m * 16) * 512 + col0;
#pragma unroll
                    for (int bj = 0; bj < 2; ++bj) { *(f32x4*)(rowp + bj * HALF) = acc[ai][bj][m][0]; *(f32x4*)(rowp + bj * HALF + 4) = acc[ai][bj][m][1]; } }
        } else {
            const int col0 = u.pn * BM + wc * 32 + 8 * fq;
#pragma unroll
            for (int ai = 0; ai < 2; ++ai)
#pragma unroll
                for (int m = 0; m < 4; ++m) { bf16_t* rowp = P + (size_t)(row0 + ai * HALF + m * 16) * INW + col0;
#pragma unroll
                    for (int bj = 0; bj < 2; ++bj) { const f32x4 v0 = acc[ai][bj][m][0], v1 = acc[ai][bj][m][1];
                        u32x4 w; w.x = cvt_pk_bf16(v0[0], v0[1]); w.y = cvt_pk_bf16(v0[2], v0[3]); w.z = cvt_pk_bf16(v1[0], v1[1]); w.w = cvt_pk_bf16(v1[2], v1[3]);
                        *(u32x4*)(rowp + bj * HALF) = w; } }
        }
    }
};
struct EpiGlu {
    const float* bglu; const bf16_t* P; bf16_t* ACT;
    static __device__ __forceinline__ bool keep(const Unit&) { return false; }
    __device__ __forceinline__ void operator()(f32x4 (&acc)[2][2][4][2], const Unit& u, int wr, int wc, int fr, int fq) const {
        const int row0 = u.pm * BM + wr * 64 + fr, col0 = u.pn * 128 + wc * 32 + 8 * fq;
        float ba[8], bg[8];
        { const f32x4 a0 = *(const f32x4*)(bglu + col0), a1 = *(const f32x4*)(bglu + col0 + 4), g0 = *(const f32x4*)(bglu + 2048 + col0), g1 = *(const f32x4*)(bglu + 2048 + col0 + 4);
#pragma unroll
          for (int j = 0; j < 4; ++j) { ba[j] = a0[j]; ba[4 + j] = a1[j]; bg[j] = g0[j]; bg[4 + j] = g1[j]; } }
#pragma unroll
        for (int ai = 0; ai < 2; ++ai)
#pragma unroll
            for (int m = 0; m < 4; ++m) { const size_t row = (size_t)(row0 + ai * HALF + m * 16);
                const u32x4 zw = *(const u32x4*)(P + row * INW + C_ZS + col0); float z[8]; unpack8(zw, z);
                float o[8];
#pragma unroll
                for (int n = 0; n < 2; ++n)
#pragma unroll
                    for (int j = 0; j < 4; ++j) { const int e = 4 * n + j; const float a = acc[ai][0][m][n][j] + ba[e], g = acc[ai][1][m][n][j] + bg[e]; o[e] = a * sigm(g) * (z[e] * sigm(z[e])); }
                u32x4 w; w.x = cvt_pk_bf16(o[0], o[1]); w.y = cvt_pk_bf16(o[2], o[3]); w.z = cvt_pk_bf16(o[4], o[5]); w.w = cvt_pk_bf16(o[6], o[7]);
                *(u32x4*)(ACT + row * DM + 2048 + col0) = w; }
    }
};
struct EpiMerge {
    const bf16_t* P; bf16_t* O;
    static __device__ __forceinline__ bool keep(const Unit& u) { return u.flag == 0; }
    __device__ __forceinline__ void operator()(f32x4 (&acc)[2][2][4][2], const Unit& u, int wr, int wc, int fr, int fq) const {
        const int row0 = u.pm * BM + wr * 64 + fr, col0 = u.pn * BM + wc * 32 + 8 * fq;
#pragma unroll
        for (int ai = 0; ai < 2; ++ai)
#pragma unroll
            for (int m = 0; m < 4; ++m) { const size_t row = (size_t)(row0 + ai * HALF + m * 16);
#pragma unroll
                for (int bj = 0; bj < 2; ++bj) { const int col = col0 + bj * HALF;
                    const u32x4 sw = *(const u32x4*)(P + row * INW + C_GS + col); float gs[8]; unpack8(sw, gs);
                    if (u.flag == 0) {
                        const u32x4 aw = *(const u32x4*)(P + row * INW + C_GA + col); float ga[8]; unpack8(aw, ga);
#pragma unroll
                        for (int n = 0; n < 2; ++n)
#pragma unroll
                            for (int j = 0; j < 4; ++j) { const int e = 4 * n + j; const float ea = __expf(-fmaxf(ga[e], -30.f)), es = __expf(-fmaxf(gs[e], -30.f)); acc[ai][bj][m][n][j] *= (1.0f + es) / (1.0f + ea); }
                    } else {
                        float o[8];
#pragma unroll
                        for (int n = 0; n < 2; ++n)
#pragma unroll
                            for (int j = 0; j < 4; ++j) { const int e = 4 * n + j; o[e] = acc[ai][bj][m][n][j] / (1.0f + __expf(-fmaxf(gs[e], -30.f))); }
                        u32x4 w; w.x = cvt_pk_bf16(o[0], o[1]); w.y = cvt_pk_bf16(o[2], o[3]); w.z = cvt_pk_bf16(o[4], o[5]); w.w = cvt_pk_bf16(o[6], o[7]);
                        *(u32x4*)(O + row * DM + col) = w;
                    } } }
    }
};
struct EpiOut {
    const float* xp; const float* xs; float* out; float* rowss;
    static __device__ __forceinline__ bool keep(const Unit&) { return false; }
    __device__ __forceinline__ void operator()(f32x4 (&acc)[2][2][4][2], const Unit& u, int wr, int wc, int fr, int fq) const {
        const int row0 = u.pm * BM + wr * 64 + fr, col0 = u.pn * BM + wc * 32 + 8 * fq;
        const float* xb = (u.pm * BM < MP) ? xp : (xs - (size_t)MP * DM);
#pragma unroll
        for (int ai = 0; ai < 2; ++ai)
#pragma unroll
            for (int m = 0; m < 4; ++m) { const size_t row = (size_t)(row0 + ai * HALF + m * 16); float ss = 0.f;
#pragma unroll
                for (int bj = 0; bj < 2; ++bj)
#pragma unroll
                    for (int n = 0; n < 2; ++n) { const size_t off = row * DM + col0 + bj * HALF + 4 * n; const f32x4 xv = *(const f32x4*)(xb + off); const f32x4 o = xv + acc[ai][bj][m][n];
                        *(f32x4*)(out + off) = o; ss += (o[0] * o[0] + o[1] * o[1]) + (o[2] * o[2] + o[3] * o[3]); }
                ss += __shfl_xor(ss, 16); ss += __shfl_xor(ss, 32);
                if (fq == 0) atomicAdd(rowss + row, ss); }
    }
};

template <class Epi, class Sched, bool ALIGN_EPI = true>
__device__ __forceinline__ void gemm_phase(LAS unsigned char* lds, const Gemm g, const Sched& S, const Epi& E) {
    const int tid = threadIdx.x, wid = __builtin_amdgcn_readfirstlane(tid >> 6), lane = tid & 63, wr = wid >> 2, wc = wid & 3, fr = lane & 15, fq = lane >> 4;
    const int K = g.K, nt = K / BK;
    unsigned voffA[2], voffB[2];
#pragma unroll
    for (int i = 0; i < 2; ++i) { int R, C; stage_rc(tid * 16 + i * 8192, R, C); const int Rb = (R & ~31) + perm32(R & 31);
        voffA[i] = (unsigned)(R * g.lda + C) * 2u; voffB[i] = (unsigned)(Rb * g.ldb + C) * 2u; }
    const size_t kstep = (size_t)(BK * 2);
    const size_t hstepA = (size_t)HALF * g.lda * 2, hstepB = (size_t)HALF * g.ldb * 2;
    const unsigned ldsw = (unsigned)wid * 1024u;
    const int aoff = lds_byte(wr * 64 + fr, fq * 8), boff = lds_byte(wc * 32 + fr, fq * 8);
#define PG8_SA(b, h) (((b) * 2 + (h)) * HTB)
#define PG8_SB(b, h) ((4 + (b) * 2 + (h)) * HTB)
#define PG8_STAGE(bufoff, gbase, voff) do { _Pragma("unroll") for (int _i = 0; _i < 2; ++_i) \
        __builtin_amdgcn_global_load_lds((const unsigned*)((const char*)(gbase) + (voff)[_i]), (LAS unsigned*)(lds + (bufoff) + ldsw + _i * 8192), 16, 0, 0); } while (0)
#define PG8_LDA(dst, b, h) do { _Pragma("unroll") for (int m = 0; m < 4; ++m) _Pragma("unroll") for (int k = 0; k < 2; ++k) dst[m][k] = *(const LAS bf16x8*)(lds + PG8_SA(b, h) + aoff + m * 2048 + k * 1024); } while (0)
#define PG8_LDB(dst, b, h) do { _Pragma("unroll") for (int n = 0; n < 2; ++n) _Pragma("unroll") for (int k = 0; k < 2; ++k) dst[n][k] = *(const LAS bf16x8*)(lds + PG8_SB(b, h) + boff + n * 2048 + k * 1024); } while (0)
#define PG8_MMA(ai, bj, At, Bt) do { __builtin_amdgcn_s_setprio(1); _Pragma("unroll") for (int m = 0; m < 4; ++m) _Pragma("unroll") for (int n = 0; n < 2; ++n) _Pragma("unroll") for (int k = 0; k < 2; ++k) \
        acc[ai][bj][m][n] = __builtin_amdgcn_mfma_f32_16x16x32_bf16(Bt[n][k], At[m][k], acc[ai][bj][m][n], 0, 0, 0); __builtin_amdgcn_s_setprio(0); } while (0)
#define PG8_WAIT_V(n) asm volatile("s_waitcnt vmcnt(" #n ")" ::: "memory")
#define PG8_WAIT_L(n) asm volatile("s_waitcnt lgkmcnt(" #n ")" ::: "memory")
#define PG8_BAR __builtin_amdgcn_s_barrier()
#define PG8_SCHED __builtin_amdgcn_sched_barrier(0)
    Unit cur, nxt; int ui = 0;
    if (!S.next(0, cur)) return;
    f32x4 acc[2][2][4][2];
#pragma unroll
    for (int a = 0; a < 2; ++a)
#pragma unroll
        for (int b = 0; b < 2; ++b)
#pragma unroll
            for (int m = 0; m < 4; ++m)
#pragma unroll
                for (int n = 0; n < 2; ++n) acc[a][b][m][n] = (f32x4){0.f, 0.f, 0.f, 0.f};
    bf16x8 At[4][2], B0[2][2], B1[2][2];
    const char* cA = (const char*)g.A + ((size_t)cur.pm * BM * g.lda + cur.acol) * 2; const char* cB = (const char*)g.Bt + (size_t)cur.brow * g.ldb * 2;
    PG8_STAGE(PG8_SB(0, 0), cB, voffB); PG8_STAGE(PG8_SB(0, 1), cB + hstepB, voffB); PG8_STAGE(PG8_SA(0, 0), cA, voffA); PG8_STAGE(PG8_SA(0, 1), cA + hstepA, voffA);
    if (wr == 1) PG8_BAR;
    PG8_WAIT_V(2); PG8_BAR;
    PG8_STAGE(PG8_SB(1, 0), cB + kstep, voffB); PG8_STAGE(PG8_SA(1, 0), cA + kstep, voffA); PG8_STAGE(PG8_SB(1, 1), cB + hstepB + kstep, voffB);
    PG8_WAIT_V(6); PG8_BAR;
    for (;;) {
        const bool has_next = S.next(ui + 1, nxt);
        const char* nA = has_next ? (const char*)g.A + ((size_t)nxt.pm * BM * g.lda + nxt.acol) * 2 : cA; const char* nB = has_next ? (const char*)g.Bt + (size_t)nxt.brow * g.ldb * 2 : cB;
        for (int t = 0; t < nt; t += 2) {
            const bool last = (t == nt - 2);
            const char* a1 = cA + (size_t)(t + 1) * kstep;
            const char* a2 = last ? nA : cA + (size_t)(t + 2) * kstep; const char* b2 = last ? nB : cB + (size_t)(t + 2) * kstep;
            const char* a3 = a2 + kstep; const char* b3 = b2 + kstep;
            PG8_LDB(B0, 0, 0); PG8_LDB(B1, 0, 1); PG8_SCHED; PG8_LDA(At, 0, 0); PG8_STAGE(PG8_SA(1, 1), a1 + hstepA, voffA);
            PG8_WAIT_V(8); PG8_WAIT_L(0); PG8_BAR; PG8_MMA(0, 0, At, B0); PG8_MMA(0, 1, At, B1); PG8_BAR; PG8_SCHED;
            PG8_LDA(At, 0, 1); PG8_STAGE(PG8_SB(0, 0), b2, voffB); PG8_STAGE(PG8_SB(0, 1), b2 + hstepB, voffB); PG8_STAGE(PG8_SA(0, 0), a2, voffA);
            PG8_WAIT_V(8); PG8_WAIT_L(0); PG8_BAR; PG8_MMA(1, 0, At, B0); PG8_MMA(1, 1, At, B1); PG8_BAR; PG8_SCHED;
            PG8_LDB(B0, 1, 0); PG8_LDB(B1, 1, 1); PG8_SCHED; PG8_LDA(At, 1, 0); PG8_STAGE(PG8_SA(0, 1), a2 + hstepA, voffA);
            PG8_WAIT_V(8); PG8_WAIT_L(0); PG8_BAR; PG8_MMA(0, 0, At, B0); PG8_MMA(0, 1, At, B1); PG8_BAR; PG8_SCHED;
            PG8_LDA(At, 1, 1); PG8_STAGE(PG8_SB(1, 0), b3, voffB); PG8_STAGE(PG8_SB(1, 1), b3 + hstepB, voffB); PG8_STAGE(PG8_SA(1, 0), a3, voffA);
            PG8_WAIT_V(8); PG8_WAIT_L(0); PG8_BAR; PG8_MMA(1, 0, At, B0); PG8_MMA(1, 1, At, B1); PG8_BAR; PG8_SCHED;
        }
        if constexpr (ALIGN_EPI) { if (wr == 0) PG8_BAR; }
        E(acc, cur, wr, wc, fr, fq);
        if (!has_next) break;
        if (!Epi::keep(cur)) {
#pragma unroll
            for (int a = 0; a < 2; ++a)
#pragma unroll
                for (int b = 0; b < 2; ++b)
#pragma unroll
                    for (int m = 0; m < 4; ++m)
#pragma unroll
                        for (int n = 0; n < 2; ++n) acc[a][b][m][n] = (f32x4){0.f, 0.f, 0.f, 0.f};
        }
        cur = nxt; cA = nA; cB = nB; ++ui;
        if constexpr (ALIGN_EPI) { if (wr == 1) PG8_BAR; }
    }
    PG8_WAIT_V(0);
    if constexpr (!ALIGN_EPI) { if (wr == 0) PG8_BAR; }
    PG8_BAR;
#undef PG8_SA
#undef PG8_SB
#undef PG8_STAGE
#undef PG8_LDA
#undef PG8_LDB
#undef PG8_MMA
#undef PG8_WAIT_V
#undef PG8_WAIT_L
#undef PG8_BAR
#undef PG8_SCHED
}
}

using pg8::cvt_pk_bf16; using pg8::bf_lo; using pg8::bf_hi; using pg8::sigm;

struct Args { const float* in[23]; float* out; unsigned char* ws; int ph_lo, ph_hi; };
enum { I_XP = 0, I_XS, I_CK, I_CV, I_SRE, I_SIM, I_NG, I_WIN, I_SINK, I_LRE, I_LIM, I_LDT, I_BRE, I_BIM, I_CRE, I_CIM, I_DSK, I_WGLU, I_BGLU, I_WPA, I_WPS, I_WOUT, I_FG };

#define LDS_WAIT() asm volatile("s_waitcnt lgkmcnt(0)" ::: "memory")
__device__ __forceinline__ unsigned f2bf(float f) { unsigned u = __float_as_uint(f); return (u + 0x7fffu + ((u >> 16) & 1u)) >> 16; }
__device__ __forceinline__ unsigned pk2(float lo, float hi) { return f2bf(lo) | (f2bf(hi) << 16); }
__device__ __forceinline__ float wave_sum(float v) {
#pragma unroll
    for (int o = 1; o < 64; o <<= 1) v += __shfl_xor(v, o);
    return v;
}
__device__ __forceinline__ void sincos_acc(double a, float& s, float& c) {
    const double q = rint(a * 0.63661977236758134308);
    double r = fma(-q, 1.57079632679489655800e+00, a); r = fma(-q, 6.12323399573676603587e-17, r);
    const double r2 = r * r;
    double sp = -7.6471637318198164759e-13; sp = fma(sp, r2, 1.6059043836821614599e-10); sp = fma(sp, r2, -2.5052108385441718775e-08); sp = fma(sp, r2, 2.7557319223985890653e-06);
    sp = fma(sp, r2, -1.9841269841269841270e-04); sp = fma(sp, r2, 8.3333333333333333333e-03); sp = fma(sp, r2, -1.6666666666666666667e-01); const double sr = fma(sp * r2, r, r);
    double cp = 4.7794773323873852974e-14; cp = fma(cp, r2, -1.1470745597729724714e-11); cp = fma(cp, r2, 2.0876756987868098979e-09); cp = fma(cp, r2, -2.7557319223985890653e-07);
    cp = fma(cp, r2, 2.4801587301587301587e-05); cp = fma(cp, r2, -1.3888888888888888889e-03); cp = fma(cp, r2, 4.1666666666666666667e-02); cp = fma(cp, r2, -0.5); const double cr = fma(cp, r2, 1.0);
    const int qi = (int)((long long)q & 3);
    const double ss = (qi == 0) ? sr : (qi == 1) ? cr : (qi == 2) ? -sr : -cr;
    const double cc = (qi == 0) ? cr : (qi == 1) ? -sr : (qi == 2) ? -cr : sr;
    s = (float)ss; c = (float)cc;
}

template <class RowMap>
__device__ __forceinline__ void p0_transpose_item(const float* W, int N, bf16_t* WT, int ldt, const RowMap& rm, LAS float* scr, int item, int lane) {
    const int nblk = N / 32, kb = item / nblk, nb = item % nblk, k0 = 64 * kb, n0 = 32 * nb;
    float tv[32];
#pragma unroll
    for (int i = 0; i < 32; ++i) { const int kk = 2 * i + (lane >> 5); tv[i] = W[(size_t)(k0 + kk) * N + n0 + (lane & 31)]; }
#pragma unroll
    for (int i = 0; i < 32; ++i) { const int kk = 2 * i + (lane >> 5); scr[kk * 33 + (lane & 31)] = tv[i]; }
    LDS_WAIT(); asm volatile("" ::: "memory");
    const int c = lane & 7;
#pragma unroll
    for (int j = 0; j < 4; ++j) { const int n = (lane >> 3) + 8 * j; const LAS float* s = scr + (8 * c) * 33 + n;
        u32x4 o; o.x = pk2(s[0 * 33], s[1 * 33]); o.y = pk2(s[2 * 33], s[3 * 33]); o.z = pk2(s[4 * 33], s[5 * 33]); o.w = pk2(s[6 * 33], s[7 * 33]);
        *(u32x4*)(WT + (size_t)rm(n0 + n) * ldt + k0 + 8 * c) = o; }
    LDS_WAIT(); asm volatile("" ::: "memory");
}
struct RmId { __device__ int operator()(int n) const { return n; } };
struct RmGlu { __device__ int operator()(int n) const { const int part = n >> 11, j = n & 2047; return ((j >> 7) << 8) + (part << 7) + (j & 127); } };
struct RmMerge { int half; __device__ int operator()(int n) const { return ((n >> 8) << 9) + (half << 8) + (n & 255); } };

__device__ __forceinline__ void p0_prologue(const Args& a, LAS unsigned char* lds, int tid, int lane, int wave, int G) {
    unsigned char* ws = a.ws;
    LAS float* scr = (LAS float*)(lds + wave * 16384);
    const int gw = blockIdx.x * NWAVES + wave, NGW = G * NWAVES;
    constexpr int I_1 = 64 * (INW / 32), I_2 = 32 * 128, I_3 = 32 * 128, I_4 = 32 * 128, I_5 = 64 * 128;
    constexpr int NITEMS = I_1 + I_2 + I_3 + I_4 + I_5;
    for (int it = gw; it < NITEMS; it += NGW) {
        int r = it;
        if (r < I_1) { p0_transpose_item(a.in[I_WIN], INW, (bf16_t*)(ws + WS_WIN), 4096, RmId{}, scr, r, lane); continue; } r -= I_1;
        if (r < I_2) { p0_transpose_item(a.in[I_WGLU], 4096, (bf16_t*)(ws + WS_WGLU), 2048, RmGlu{}, scr, r, lane); continue; } r -= I_2;
        if (r < I_3) { p0_transpose_item(a.in[I_WPA], 4096, (bf16_t*)(ws + WS_WM), 2048, RmMerge{0}, scr, r, lane); continue; } r -= I_3;
        if (r < I_4) { p0_transpose_item(a.in[I_WPS], 4096, (bf16_t*)(ws + WS_WM), 2048, RmMerge{1}, scr, r, lane); continue; } r -= I_4;
        p0_transpose_item(a.in[I_WOUT], 4096, (bf16_t*)(ws + WS_WOUT), 4096, RmId{}, scr, r, lane);
    }
    const float* ng = a.in[I_NG];
    for (int m = gw; m < MT; m += NGW) {
        const float* xrow = (m < MP) ? a.in[I_XP] + (size_t)m * DM : a.in[I_XS] + (size_t)(m - MP) * DM;
        const f32x4* xr = (const f32x4*)xrow + lane;
        f32x4 v[16]; float s = 0.f;
#pragma unroll
        for (int j = 0; j < 16; ++j) { v[j] = xr[64 * j]; s += (v[j].x * v[j].x + v[j].y * v[j].y) + (v[j].z * v[j].z + v[j].w * v[j].w); }
        const float rs = 1.0f / sqrtf(wave_sum(s) * (1.0f / DM) + EPS);
        u32x2* o8 = (u32x2*)((bf16_t*)(ws + WS_XN) + (size_t)m * DM) + lane;
#pragma unroll
        for (int j = 0; j < 16; ++j) { const f32x4 gg = *((const f32x4*)ng + lane + 64 * j); u32x2 w; w.x = pk2(v[j].x * rs * gg.x, v[j].y * rs * gg.y); w.y = pk2(v[j].z * rs * gg.z, v[j].w * rs * gg.w); o8[64 * j] = w; }
    }
    const int gt = blockIdx.x * (NWAVES * 64) + tid, NGT = G * NWAVES * 64;
    for (int e = gt; e < NG * SD; e += NGT) {
        const int g = e >> 6;
        const float lr = fminf(a.in[I_LRE][e], -1e-4f), li = a.in[I_LIM][e], dt = expf(a.in[I_LDT][g]);
        const float mag = expf(lr * dt), ang = li * dt; float sn, cs; sincos_acc((double)ang, sn, cs);
        const float are = mag * cs, aim = mag * sn;
        const float den = lr * lr + li * li, nr = are - 1.0f;
        const float fre = (nr * lr + aim * li) / den, fim = (aim * lr - nr * li) / den;
        ((float*)(ws + WS_ARE))[e] = are; ((float*)(ws + WS_AIM))[e] = aim;
        float s64, c64; sincos_acc(64.0 * (double)ang, s64, c64); const float m64 = expf(64.0f * (lr * dt));
        ((float*)(ws + WS_A64R))[e] = m64 * c64; ((float*)(ws + WS_A64I))[e] = m64 * s64;
        const float* br = a.in[I_BRE] + (size_t)e * 16; const float* bi = a.in[I_BIM] + (size_t)e * 16;
        float* obr = (float*)(ws + WS_BBR) + (size_t)e * 16; float* obi = (float*)(ws + WS_BBI) + (size_t)e * 16;
#pragma unroll
        for (int i = 0; i < 16; ++i) { const float b_r = br[i], b_i = bi[i]; obr[i] = fre * b_r - fim * b_i; obi[i] = fre * b_i + fim * b_r; }
    }
    for (int e = gt; e < 4096 * 32; e += NGT) {
        const int pos = e >> 5, j = e & 31;
        const float invf = (float)exp2(-(double)j * (13.287712379549449 / 32.0));
        const float ang = (float)pos * invf; float sn, cs; sincos_acc((double)ang, sn, cs);
        ((float*)(ws + WS_ROPC))[e] = cs; ((float*)(ws + WS_ROPS))[e] = sn;
    }
    for (int e = gt; e < MT; e += NGT) ((float*)(ws + WS_ROWSS))[e] = 0.f;
}

constexpr int KS_STRIDE = 72, VT_STRIDE = 200, VT_OFF = 192 * KS_STRIDE * 2;
__device__ __forceinline__ void attn_item(const Args& a, LAS unsigned char* lds, int item, int tid, int lane, int wave) {
    unsigned char* ws = a.ws;
    const bf16_t* P = (const bf16_t*)(ws + WS_PROJ); const float* KV = (const float*)(ws + WS_KV);
    const float* RC = (const float*)(ws + WS_ROPC); const float* RS = (const float*)(ws + WS_ROPS);
    bf16_t* ACT = (bf16_t*)(ws + WS_ACT);
    int s, c, g; const bool samp = item >= NB * NCH * NKV;
    if (!samp) { g = item & 3; c = (item >> 2) & 63; s = item >> 8; } else { const int r = item - NB * NCH * NKV; g = r & 3; c = 0; s = r >> 2; }
    const int m0 = samp ? MP + s * 64 : s * SEQ + c * 64;
    const int pos0 = samp ? PAST : c * 64;
    LAS bf16_t* Ks = (LAS bf16_t*)lds; LAS bf16_t* Vt = (LAS bf16_t*)(lds + VT_OFF);
    __syncthreads();
#pragma unroll
    for (int r = 0; r < 3; ++r) {
        const int idx = tid + 512 * r, kk = idx >> 3, d0 = (idx & 7) * 4;
        f32x4 k1 = {0.f, 0.f, 0.f, 0.f}, k2 = {0.f, 0.f, 0.f, 0.f};
        if (samp && kk < 128) {
            const float* src = a.in[I_CK] + ((size_t)(s * 128 + kk) * 4 + g) * 64 + d0; k1 = *(const f32x4*)src; k2 = *(const f32x4*)(src + 32);
        } else {
            const int tok = samp ? (kk - 128) : (c - 2) * 64 + kk;
            if (tok >= 0) {
                const int m = samp ? MP + s * 64 + tok : s * SEQ + tok; const int pos = samp ? PAST + tok : tok;
                const float* src = KV + (size_t)m * 512 + g * 64 + d0; const f32x4 x1 = *(const f32x4*)src, x2 = *(const f32x4*)(src + 32);
                const f32x4 cs = *(const f32x4*)(RC + pos * 32 + d0), sn = *(const f32x4*)(RS + pos * 32 + d0);
                k1 = x1 * cs - x2 * sn; k2 = x2 * cs + x1 * sn;
                if (kk >= 128) {
                    if (samp) { float* o = a.out + O_KS + ((size_t)(s * 64 + tok) * 4 + g) * 64 + d0; *(f32x4*)o = k1; *(f32x4*)(o + 32) = k2; }
                    else if (c >= NCH - 2) { float* o = a.out + O_KP + ((size_t)(s * 128 + (tok - (SEQ - 128))) * 4 + g) * 64 + d0; *(f32x4*)o = k1; *(f32x4*)(o + 32) = k2; }
                }
            }
        }
        u32x2 w1, w2; w1.x = pk2(k1.x, k1.y); w1.y = pk2(k1.z, k1.w); w2.x = pk2(k2.x, k2.y); w2.y = pk2(k2.z, k2.w);
        *(LAS u32x2*)(Ks + kk * KS_STRIDE + d0) = w1; *(LAS u32x2*)(Ks + kk * KS_STRIDE + 32 + d0) = w2;
    }
#pragma unroll
    for (int r = 0; r < 6; ++r) {
        const int idx = tid + 512 * r, kk = idx >> 4, d0 = (idx & 15) * 4;
        f32x4 v = {0.f, 0.f, 0.f, 0.f};
        if (samp && kk < 128) { v = *(const f32x4*)(a.in[I_CV] + ((size_t)(s * 128 + kk) * 4 + g) * 64 + d0); }
        else {
            const int tok = samp ? (kk - 128) : (c - 2) * 64 + kk;
            if (tok >= 0) {
                const int m = samp ? MP + s * 64 + tok : s * SEQ + tok;
                v = *(const f32x4*)(KV + (size_t)m * 512 + 256 + g * 64 + d0);
                if (kk >= 128) {
                    if (samp) *(f32x4*)(a.out + O_VS + ((size_t)(s * 64 + tok) * 4 + g) * 64 + d0) = v;
                    else if (c >= NCH - 2) *(f32x4*)(a.out + O_VP + ((size_t)(s * 128 + (tok - (SEQ - 128))) * 4 + g) * 64 + d0) = v;
                }
            }
        }
        Vt[(d0 + 0) * VT_STRIDE + kk] = (bf16_t)f2bf(v.x); Vt[(d0 + 1) * VT_STRIDE + kk] = (bf16_t)f2bf(v.y);
        Vt[(d0 + 2) * VT_STRIDE + kk] = (bf16_t)f2bf(v.z); Vt[(d0 + 3) * VT_STRIDE + kk] = (bf16_t)f2bf(v.w);
    }
    __syncthreads();
    const int fr = lane & 15, fq = lane >> 4, h = g * 8 + wave;
    const float sink = a.in[I_SINK][h];
    const int jb_min = (!samp && c < 2) ? (2 - c) * 4 : 0;
    for (int tb = 0; tb < 4; ++tb) {
        const int tok = tb * 16 + fr; const size_t m = (size_t)(m0 + tok); const int pos = pos0 + tok;
        const bf16_t* qp = P + m * INW + C_Q + h * 64 + fq * 8;
        const u32x4 qa = *(const u32x4*)qp, qb = *(const u32x4*)(qp + 32);
        float q1[8], q2[8]; pg8::unpack8(qa, q1); pg8::unpack8(qb, q2);
        const f32x4 c0 = *(const f32x4*)(RC + pos * 32 + fq * 8), c1 = *(const f32x4*)(RC + pos * 32 + fq * 8 + 4);
        const f32x4 s0 = *(const f32x4*)(RS + pos * 32 + fq * 8), s1 = *(const f32x4*)(RS + pos * 32 + fq * 8 + 4);
        float r1[8], r2[8];
#pragma unroll
        for (int j = 0; j < 8; ++j) { const float cs = j < 4 ? c0[j & 3] : c1[j & 3], sn = j < 4 ? s0[j & 3] : s1[j & 3]; r1[j] = (q1[j] * cs - q2[j] * sn) * 0.125f; r2[j] = (q2[j] * cs + q1[j] * sn) * 0.125f; }
        u32x4 w0, w1; w0.x = cvt_pk_bf16(r1[0], r1[1]); w0.y = cvt_pk_bf16(r1[2], r1[3]); w0.z = cvt_pk_bf16(r1[4], r1[5]); w0.w = cvt_pk_bf16(r1[6], r1[7]);
        w1.x = cvt_pk_bf16(r2[0], r2[1]); w1.y = cvt_pk_bf16(r2[2], r2[3]); w1.z = cvt_pk_bf16(r2[4], r2[5]); w1.w = cvt_pk_bf16(r2[6], r2[7]);
        const bf16x8 qf0 = __builtin_bit_cast(bf16x8, w0), qf1 = __builtin_bit_cast(bf16x8, w1);
        f32x4 sc[12];
#pragma unroll
        for (int jb = 0; jb < 12; ++jb) {
            const LAS bf16_t* kp = Ks + (jb * 16 + fr) * KS_STRIDE + fq * 8;
            const bf16x8 kf0 = *(const LAS bf16x8*)kp, kf1 = *(const LAS bf16x8*)(kp + 32);
            f32x4 z = {0.f, 0.f, 0.f, 0.f};
            z = __builtin_amdgcn_mfma_f32_16x16x32_bf16(kf0, qf0, z, 0, 0, 0);
            sc[jb] = __builtin_amdgcn_mfma_f32_16x16x32_bf16(kf1, qf1, z, 0, 0, 0);
        }
        float mx = sink;
#pragma unroll
        for (int jb = 0; jb < 12; ++jb) if (jb >= jb_min) { mx = fmaxf(mx, fmaxf(fmaxf(sc[jb][0], sc[jb][1]), fmaxf(sc[jb][2], sc[jb][3]))); }
        mx = fmaxf(mx, __shfl_xor(mx, 16)); mx = fmaxf(mx, __shfl_xor(mx, 32));
        float l = 0.f;
#pragma unroll
        for (int jb = 0; jb < 12; ++jb) {
#pragma unroll
            for (int j = 0; j < 4; ++j) { const float p = (jb >= jb_min) ? __expf(sc[jb][j] - mx) : 0.f; sc[jb][j] = p; l += p; } }
        l += __shfl_xor(l, 16); l += __shfl_xor(l, 32);
        l += __expf(sink - mx);
        const float inv = 1.0f / l;
        bf16x8 pa[6];
#pragma unroll
        for (int i = 0; i < 6; ++i) { u32x4 w; w.x = cvt_pk_bf16(sc[2 * i][0] * inv, sc[2 * i][1] * inv); w.y = cvt_pk_bf16(sc[2 * i][2] * inv, sc[2 * i][3] * inv);
            w.z = cvt_pk_bf16(sc[2 * i + 1][0] * inv, sc[2 * i + 1][1] * inv); w.w = cvt_pk_bf16(sc[2 * i + 1][2] * inv, sc[2 * i + 1][3] * inv); pa[i] = __builtin_bit_cast(bf16x8, w); }
#pragma unroll
        for (int db = 0; db < 4; ++db) {
            f32x4 o = {0.f, 0.f, 0.f, 0.f};
            const LAS bf16_t* vp = Vt + (db * 16 + fr) * VT_STRIDE + fq * 4;
#pragma unroll
            for (int i = 0; i < 6; ++i) { const u32x2 va = *(const LAS u32x2*)(vp + (2 * i) * 16), vb = *(const LAS u32x2*)(vp + (2 * i + 1) * 16);
                u32x4 w; w.x = va.x; w.y = va.y; w.z = vb.x; w.w = vb.y;
                o = __builtin_amdgcn_mfma_f32_16x16x32_bf16(pa[i], __builtin_bit_cast(bf16x8, w), o, 0, 0, 0); }
#pragma unroll
            for (int j = 0; j < 4; ++j) { const size_t mm = (size_t)(m0 + tb * 16 + fq * 4 + j); const int col = h * 64 + db * 16 + fr;
                const float z = bf_lo((unsigned)P[mm * INW + C_ZA + col]); ACT[mm * DM + col] = (bf16_t)f2bf(o[j] * z * sigm(z)); }
        }
    }
}

constexpr int HB_STRIDE = 136;
template <bool FULL>
__device__ __forceinline__ void ssm_run(const Args& a, LAS unsigned char* wl, int s, int g, int c0, int c1, int lane) {
    unsigned char* ws = a.ws;
    const bf16_t* P = (const bf16_t*)(ws + WS_PROJ);
    const bool samp = s >= NB; const int sb = s - NB;
    LAS float* uf = (LAS float*)wl;
    LAS bf16_t* hb = (LAS bf16_t*)(wl + 4096);
    const int e = g * 64 + lane;
    const float are = ((const float*)(ws + WS_ARE))[e], aim = ((const float*)(ws + WS_AIM))[e];
    float bbr[16], bbi[16];
    { const f32x4* pr = (const f32x4*)((const float*)(ws + WS_BBR) + (size_t)e * 16); const f32x4* pi = (const f32x4*)((const float*)(ws + WS_BBI) + (size_t)e * 16);
#pragma unroll
      for (int q = 0; q < 4; ++q) { const f32x4 x = pr[q], y = pi[q];
#pragma unroll
          for (int j = 0; j < 4; ++j) { bbr[q * 4 + j] = x[j]; bbi[q * 4 + j] = y[j]; } } }
    const int fr = lane & 15, fq = lane >> 4;
    bf16x8 cf[4]; f32x4 dsk = {0.f, 0.f, 0.f, 0.f};
    float hr = 0.f, hi = 0.f;
    if constexpr (FULL) {
#pragma unroll
        for (int kb = 0; kb < 4; ++kb) { const size_t off = (size_t)(g * 16 + fr) * 64 + kb * 16 + fq * 4;
            const f32x4 x = *(const f32x4*)(a.in[I_CRE] + off), y = *(const f32x4*)(a.in[I_CIM] + off);
            u32x4 w; w.x = pk2(x[0], -y[0]); w.y = pk2(x[1], -y[1]); w.z = pk2(x[2], -y[2]); w.w = pk2(x[3], -y[3]); cf[kb] = __builtin_bit_cast(bf16x8, w); }
        dsk = *(const f32x4*)(a.in[I_DSK] + g * 16 + fq * 4);
        if (samp) { hr = a.in[I_SRE][(size_t)(sb * NG + g) * 64 + lane]; hi = a.in[I_SIM][(size_t)(sb * NG + g) * 64 + lane]; }
        else {
            const float a64r = ((const float*)(ws + WS_A64R))[e], a64i = ((const float*)(ws + WS_A64I))[e];
            const float* E = (const float*)(ws + WS_E) + ((size_t)(s * NCH) * NG + g) * 128 + lane;
            int j0 = 0;
            for (; j0 + 8 <= c0; j0 += 8) { float er[8], ei[8];
#pragma unroll
                for (int q = 0; q < 8; ++q) { er[q] = E[(size_t)(j0 + q) * NG * 128]; ei[q] = E[(size_t)(j0 + q) * NG * 128 + 64]; }
#pragma unroll
                for (int q = 0; q < 8; ++q) { const float nr = a64r * hr - a64i * hi + er[q], ni = a64r * hi + a64i * hr + ei[q]; hr = nr; hi = ni; } }
            for (; j0 < c0; ++j0) { const float er = E[(size_t)j0 * NG * 128], ei = E[(size_t)j0 * NG * 128 + 64];
                const float nr = a64r * hr - a64i * hi + er, ni = a64r * hi + a64i * hr + ei; hr = nr; hi = ni; }
        }
    }
    unsigned un[8];
    { const int m0 = samp ? MP + sb * 64 : s * SEQ + c0 * 64;
#pragma unroll
      for (int r = 0; r < 8; ++r) un[r] = *(const unsigned*)(P + (size_t)(m0 + r * 8 + (lane >> 3)) * INW + C_U + g * 16 + (lane & 7) * 2); }
    for (int c = c0; c < c1; ++c) {
        const int m0 = samp ? MP + sb * 64 : s * SEQ + c * 64;
        LDS_WAIT(); asm volatile("" ::: "memory");
#pragma unroll
        for (int r = 0; r < 8; ++r) { f32x2 v; v.x = bf_lo(un[r]); v.y = bf_hi(un[r]); *(LAS f32x2*)(uf + (r * 8 + (lane >> 3)) * 16 + (lane & 7) * 2) = v; }
        if (c + 1 < c1) {
#pragma unroll
            for (int r = 0; r < 8; ++r) un[r] = *(const unsigned*)(P + (size_t)(m0 + 64 + r * 8 + (lane >> 3)) * INW + C_U + g * 16 + (lane & 7) * 2); }
        LDS_WAIT(); asm volatile("" ::: "memory");
        if constexpr (!FULL) { hr = 0.f; hi = 0.f; }
        for (int tb = 0; tb < 4; ++tb) {
#pragma unroll
            for (int tt = 0; tt < 16; ++tt) {
                const LAS f32x4* up = (const LAS f32x4*)(uf + (tb * 16 + tt) * 16);
                const f32x4 u0 = up[0], u1 = up[1], u2 = up[2], u3 = up[3];
                float xr = 0.f, xi = 0.f, xr2 = 0.f, xi2 = 0.f;
#pragma unroll
                for (int j = 0; j < 4; ++j) { xr = fmaf(bbr[j], u0[j], xr); xi = fmaf(bbi[j], u0[j], xi); }
#pragma unroll
                for (int j = 0; j < 4; ++j) { xr2 = fmaf(bbr[4 + j], u1[j], xr2); xi2 = fmaf(bbi[4 + j], u1[j], xi2); }
#pragma unroll
                for (int j = 0; j < 4; ++j) { xr = fmaf(bbr[8 + j], u2[j], xr); xi = fmaf(bbi[8 + j], u2[j], xi); }
#pragma unroll
                for (int j = 0; j < 4; ++j) { xr2 = fmaf(bbr[12 + j], u3[j], xr2); xi2 = fmaf(bbi[12 + j], u3[j], xi2); }
                xr += xr2; xi += xi2;
                const float nr = fmaf(are, hr, fmaf(-aim, hi, xr)), ni = fmaf(are, hi, fmaf(aim, hr, xi)); hr = nr; hi = ni;
                if constexpr (FULL) *(LAS unsigned*)(hb + tt * HB_STRIDE + 2 * lane) = cvt_pk_bf16(hr, hi);
            }
            if constexpr (FULL) {
                LDS_WAIT(); asm volatile("" ::: "memory");
                f32x4 y = {0.f, 0.f, 0.f, 0.f};
#pragma unroll
                for (int kb = 0; kb < 4; ++kb) { const bf16x8 hf = *(const LAS bf16x8*)(hb + fr * HB_STRIDE + kb * 32 + fq * 8); y = __builtin_amdgcn_mfma_f32_16x16x32_bf16(cf[kb], hf, y, 0, 0, 0); }
                const f32x4 uu = *(const LAS f32x4*)(uf + (tb * 16 + fr) * 16 + fq * 4);
                u32x2 w; w.x = cvt_pk_bf16(y[0] + dsk[0] * uu[0], y[1] + dsk[1] * uu[1]); w.y = cvt_pk_bf16(y[2] + dsk[2] * uu[2], y[3] + dsk[3] * uu[3]);
                *(u32x2*)((bf16_t*)(ws + WS_YSSM) + (size_t)(m0 + tb * 16 + fr) * SW + g * 16 + fq * 4) = w;
                LDS_WAIT(); asm volatile("" ::: "memory");
            }
        }
        if constexpr (!FULL) { float* E = (float*)(ws + WS_E) + ((size_t)(s * NCH + c) * NG + g) * 128 + lane; E[0] = hr; E[64] = hi; }
    }
    if constexpr (FULL) {
        if (samp) { a.out[O_HRS + (size_t)(sb * NG + g) * 64 + lane] = hr; a.out[O_HIS + (size_t)(sb * NG + g) * 64 + lane] = hi; }
        else if (c1 == NCH) { a.out[O_HRP + (size_t)(s * NG + g) * 64 + lane] = hr; a.out[O_HIP + (size_t)(s * NG + g) * 64 + lane] = hi; }
    }
    LDS_WAIT(); asm volatile("" ::: "memory");
}

__global__ void __launch_bounds__(NWAVES * 64, 2) fwd_kernel(Args args) {
    extern __shared__ __attribute__((aligned(16))) unsigned char lds_raw[];
    LAS unsigned char* lds = (LAS unsigned char*)lds_raw;
    const int tid = threadIdx.x, lane = tid & 63, wave = __builtin_amdgcn_readfirstlane(tid >> 6);
    const int G = gridDim.x;
    unsigned char* ws = args.ws;
    const int lo = args.ph_lo, hi = args.ph_hi;
#define IN(k) (lo <= (k) && (k) < hi)
#define SEAM(k) do { if (IN(k) && IN((k) + 1)) cg::this_grid().sync(); } while (0)

    for (int rep = 0; rep < ((PROBE_DBL & 1) ? 2 : 1); ++rep)
    if (IN(0)) { p0_prologue(args, lds, tid, lane, wave, G); }
    SEAM(0);
    if (IN(1)) {
        pg8::Gemm g{(const bf16_t*)(ws + WS_XN), (const bf16_t*)(ws + WS_WIN), DM, DM, DM}; pg8::StaticOrder S; S.init(MT, INW, G, (int)blockIdx.x);
        pg8::EpiProj E{(bf16_t*)(ws + WS_PROJ), (float*)(ws + WS_KV)};
        pg8::gemm_phase<pg8::EpiProj, pg8::StaticOrder>(lds, g, S, E);
    }
    SEAM(1);
    for (int rep = 0; rep < ((PROBE_DBL & 4) ? 2 : 1); ++rep)
    if (IN(2)) {
        constexpr int NATT = NB * NCH * NKV + DB * NKV;
        for (int it = blockIdx.x; it < NATT; it += G) attn_item(args, lds, it, tid, lane, wave);
        __syncthreads();
        const int gw = blockIdx.x * NWAVES + wave, NGW = G * NWAVES;
        for (int w = gw; w < NB * NG * 8; w += NGW) { const int cb = w & 7, g = (w >> 3) & 127, s = w >> 10; ssm_run<false>(args, lds + wave * 16384, s, g, cb * 8, cb * 8 + 8, lane); }
        for (int w = gw; w < DB * NG; w += NGW) { const int g = w & 127, sb = w >> 7; ssm_run<true>(args, lds + wave * 16384, NB + sb, g, 0, 1, lane); }
    }
    SEAM(2);
    for (int rep = 0; rep < ((PROBE_DBL & 8) ? 2 : 1); ++rep)
    if (IN(3)) {
        const int gw = blockIdx.x * NWAVES + wave, NGW = G * NWAVES;
        for (int w = gw; w < NB * NG * 8; w += NGW) { const int cb = w & 7, g = (w >> 3) & 127, s = w >> 10; ssm_run<true>(args, lds + wave * 16384, s, g, cb * 8, cb * 8 + 8, lane); }
    }
    SEAM(3);
    if (IN(4)) {
        pg8::Gemm g{(const bf16_t*)(ws + WS_YSSM), (const bf16_t*)(ws + WS_WGLU), SW, SW, SW}; pg8::StaticOrder S; S.init(MT, 4096, G, (int)blockIdx.x);
        pg8::EpiGlu E{args.in[I_BGLU], (const bf16_t*)(ws + WS_PROJ), (bf16_t*)(ws + WS_ACT)};
        pg8::gemm_phase<pg8::EpiGlu, pg8::StaticOrder>(lds, g, S, E);
    }
    SEAM(4);
    if (IN(5)) {
        pg8::Gemm g{(const bf16_t*)(ws + WS_ACT), (const bf16_t*)(ws + WS_WM), DM, 2048, 2048}; pg8::MergeOrder S; S.S.init(MT, 4096, G, (int)blockIdx.x);
        pg8::EpiMerge E{(const bf16_t*)(ws + WS_PROJ), (bf16_t*)(ws + WS_XN)};
        pg8::gemm_phase<pg8::EpiMerge, pg8::MergeOrder>(lds, g, S, E);
    }
    SEAM(5);
    if (IN(6)) {
        pg8::Gemm g{(const bf16_t*)(ws + WS_XN), (const bf16_t*)(ws + WS_WOUT), DM, DM, DM}; pg8::StaticOrder S; S.init(MT, 4096, G, (int)blockIdx.x);
        pg8::EpiOut E{args.in[I_XP], args.in[I_XS], args.out + O_Y, (float*)(ws + WS_ROWSS)};
        pg8::gemm_phase<pg8::EpiOut, pg8::StaticOrder>(lds, g, S, E);
    }
    SEAM(6);
    if (IN(7)) {
        const int gw = blockIdx.x * NWAVES + wave, NGW = G * NWAVES;
        const float* fg = args.in[I_FG]; const float* rss = (const float*)(ws + WS_ROWSS);
        for (int m = gw; m < MT; m += NGW) {
            const float rs = 1.0f / sqrtf(rss[m] * (1.0f / DM) + EPS);
            f32x4* row = (f32x4*)(args.out + O_Y + (size_t)m * DM) + lane;
#pragma unroll
            for (int j = 0; j < 16; ++j) { const f32x4 gg = *((const f32x4*)fg + lane + 64 * j); f32x4 v = row[64 * j]; v = v * rs * gg; row[64 * j] = v; }
        }
    }
#undef IN
#undef SEAM
}

extern "C" void kernel_launch(void* const* d_in, const int* in_sizes, int n_in, void* d_out, int out_size, void* d_ws, size_t ws_size, hipStream_t stream) {
    static int grid = 0;
    if (grid == 0) {
        if (n_in != 23 || (size_t)out_size != O_END || ws_size < WS_END) { fprintf(stderr, "kernel_launch: unexpected shapes: n_in %d out %d (want %zu) ws %zu (want >= %zu)\n", n_in, out_size, (size_t)O_END, ws_size, (size_t)WS_END); grid = -1; return; }
        int dev = 0, cus = 0, per_cu = 0;
        hipGetDevice(&dev); hipDeviceGetAttribute(&cus, hipDeviceAttributeMultiprocessorCount, dev);
        if (hipFuncSetAttribute((const void*)fwd_kernel, hipFuncAttributeMaxDynamicSharedMemorySize, LDS_BYTES) != hipSuccess) { fprintf(stderr, "kernel_launch: hipFuncSetAttribute failed\n"); grid = -1; return; }
        hipOccupancyMaxActiveBlocksPerMultiprocessor(&per_cu, (const void*)fwd_kernel, NWAVES * 64, LDS_BYTES);
        if (per_cu < 1) { fprintf(stderr, "kernel_launch: occupancy query says %d blocks per CU\n", per_cu); per_cu = 1; }
        (void)hipGetLastError();
        grid = cus;
    }
    if (grid < 0) return;
    Args a{};
    for (int i = 0; i < 23; ++i) a.in[i] = (const float*)d_in[i];
    a.out = (float*)d_out; a.ws = (unsigned char*)d_ws;
#if MK_MULTI
    for (int ph = 0; ph < 8; ++ph) { a.ph_lo = ph; a.ph_hi = ph + 1; hipLaunchKernelGGL(fwd_kernel, dim3(grid), dim3(NWAVES * 64), LDS_BYTES, stream, a); }
#else
    a.ph_lo = 0; a.ph_hi = 8;
    void* kargs[] = {&a};
    hipError_t e = hipLaunchCooperativeKernel((const void*)fwd_kernel, dim3(grid), dim3(NWAVES * 64), kargs, LDS_BYTES, stream);
    if (e != hipSuccess) fprintf(stderr, "kernel_launch: cooperative launch failed: %s (grid %d)\n", hipGetErrorString(e), grid);
#endif
}
```
